# Optimizing an MI355X kernel written in HIP

```python
import jax, jax.numpy as jnp
from jax import lax
import numpy as np

D_MODEL = 1024
BATCH = 4
SEQ = 8192
DEPTH = 2

CHUNK = 64
N_MIXERS = 2
N_MEM = 256
XATTN_HEADS = 4
XATTN_HEAD_DIM = 64
XATTN_WIDTH = XATTN_HEADS * XATTN_HEAD_DIM
MIX_WIDTH = D_MODEL - XATTN_WIDTH
CONV_WIDTH = 3
POOL_WINDOWS = (2, 4, 8, 16)
POOL_GROUPS = len(POOL_WINDOWS)
POOL_GROUP_DIM = MIX_WIDTH // POOL_GROUPS
D_FF = 2816
RMS_EPS = 1e-6
N_LAYERS_A = (DEPTH + 1) // 2
N_LAYERS_B = DEPTH // 2

kernel_name = "hybrid_conv_pool_memxattn_macaron"


def rms_norm(x, g):
    xf = x.astype(jnp.float32)
    y = xf * lax.rsqrt(jnp.mean(xf * xf, axis=-1, keepdims=True) + RMS_EPS)
    return (y * g.astype(jnp.float32)).astype(x.dtype)


def swiglu(h, w_gu, w_down):
    g, u = jnp.split(h @ w_gu, 2, axis=-1)
    return (jax.nn.silu(g) * u) @ w_down


def causal_short_conv(u, w):
    s = u.shape[1]
    up = jnp.pad(u, ((0, 0), (CONV_WIDTH - 1, 0), (0, 0)))
    y = w[0] * up[:, 0:s]
    for k in range(1, CONV_WIDTH):
        y = y + w[k] * up[:, k:k + s]
    return y


def multiscale_pool(p, w_group, scale):
    s = p.shape[1]
    pos = jnp.arange(s, dtype=jnp.float32)[None, :, None]
    outs = []
    for gi, win in enumerate(POOL_WINDOWS):
        pg = p[..., gi * POOL_GROUP_DIM:(gi + 1) * POOL_GROUP_DIM]
        pf = pg.astype(jnp.float32)
        csum = jnp.cumsum(pf, axis=1)
        cfull = jnp.pad(csum, ((0, 0), (1, 0), (0, 0)))
        lower = jnp.pad(cfull[:, :s - win + 1], ((0, 0), (win - 1, 0), (0, 0)))
        count = jnp.minimum(pos + 1.0, float(win))
        mean = (csum - lower) / count
        outs.append(((mean - pf).astype(p.dtype)) @ w_group[gi])
    return jnp.concatenate(outs, axis=-1) * scale


def mem_cross_attn(q, mem_h, w_kv):
    b, s, _ = q.shape
    k, v = jnp.split(mem_h @ w_kv, 2, axis=-1)
    qh = q.reshape(b, s, XATTN_HEADS, XATTN_HEAD_DIM)
    kh = k.reshape(b, N_MEM, XATTN_HEADS, XATTN_HEAD_DIM)
    vh = v.reshape(b, N_MEM, XATTN_HEADS, XATTN_HEAD_DIM)
    scores = jnp.einsum('bshd,bmhd->bhsm', qh, kh).astype(jnp.float32) * (XATTN_HEAD_DIM ** -0.5)
    probs = jax.nn.softmax(scores, axis=-1).astype(q.dtype)
    out = jnp.einsum('bhsm,bmhd->bshd', probs, vh)
    return out.reshape(b, s, XATTN_WIDTH)


def setup_inputs(seed: int = 0) -> dict:
    key = jax.random.key(seed)
    ks = jax.random.split(key, 24)
    f32 = jnp.float32

    def nrm(k, shape, scale):
        return jax.random.normal(k, shape, f32) * scale

    def gain(k, shape):
        return 1.0 + 0.05 * jax.random.normal(k, shape, f32)

    return {
        "x": jax.random.normal(ks[0], (BATCH, SEQ, D_MODEL), f32),
        "mem": jax.random.normal(ks[1], (BATCH, N_MEM, D_MODEL), f32),
        "ffn1_norm": gain(ks[2], (DEPTH, D_MODEL)),
        "ffn1_w_gu": nrm(ks[3], (DEPTH, D_MODEL, 2 * D_FF), D_MODEL ** -0.5),
        "ffn1_w_down": nrm(ks[4], (DEPTH, D_FF, D_MODEL), D_FF ** -0.5),
        "mix_norm": gain(ks[5], (DEPTH, D_MODEL)),
        "mem_norm": gain(ks[6], (DEPTH, D_MODEL)),
        "w_kv": nrm(ks[7], (DEPTH, D_MODEL, 2 * XATTN_WIDTH), D_MODEL ** -0.5),
        "w_out": nrm(ks[8], (DEPTH, D_MODEL, D_MODEL), D_MODEL ** -0.5),
        "conv_w_in": nrm(ks[9], (N_LAYERS_A, D_MODEL, 3 * MIX_WIDTH + XATTN_WIDTH), D_MODEL ** -0.5),
        "conv_w": nrm(ks[10], (N_LAYERS_A, CONV_WIDTH, MIX_WIDTH), CONV_WIDTH ** -0.5),
        "pool_w_in": nrm(ks[11], (N_LAYERS_B, D_MODEL, MIX_WIDTH + XATTN_WIDTH), D_MODEL ** -0.5),
        "pool_w_group": nrm(ks[12], (N_LAYERS_B, POOL_GROUPS, POOL_GROUP_DIM, POOL_GROUP_DIM), POOL_GROUP_DIM ** -0.5),
        "pool_scale": 1.0 + 0.1 * jax.random.normal(ks[13], (N_LAYERS_B, MIX_WIDTH), f32),
        "ffn2_norm": gain(ks[14], (DEPTH, D_MODEL)),
        "ffn2_w_gu": nrm(ks[15], (DEPTH, D_MODEL, 2 * D_FF), D_MODEL ** -0.5),
        "ffn2_w_down": nrm(ks[16], (DEPTH, D_FF, D_MODEL), D_FF ** -0.5),
        "final_norm": gain(ks[17], (D_MODEL,)),
    }


def reference(x, mem, ffn1_norm, ffn1_w_gu, ffn1_w_down, mix_norm, mem_norm, w_kv, w_out,
              conv_w_in, conv_w, pool_w_in, pool_w_group, pool_scale,
              ffn2_norm, ffn2_w_gu, ffn2_w_down, final_norm):
    ia = 0
    ib = 0
    for i in range(DEPTH):
        x = x + 0.5 * swiglu(rms_norm(x, ffn1_norm[i]), ffn1_w_gu[i], ffn1_w_down[i])
        h = rms_norm(x, mix_norm[i])
        mem_h = rms_norm(mem, mem_norm[i])
        if i % N_MIXERS == 0:
            z = h @ conv_w_in[ia]
            gate_b = z[..., :MIX_WIDTH]
            gate_c = z[..., MIX_WIDTH:2 * MIX_WIDTH]
            val = z[..., 2 * MIX_WIDTH:3 * MIX_WIDTH]
            q = z[..., 3 * MIX_WIDTH:]
            mix = gate_b * causal_short_conv(gate_c * val, conv_w[ia])
            ia += 1
        else:
            z = h @ pool_w_in[ib]
            mix = multiscale_pool(z[..., :MIX_WIDTH], pool_w_group[ib], pool_scale[ib])
            q = z[..., MIX_WIDTH:]
            ib += 1
        att = mem_cross_attn(q, mem_h, w_kv[i])
        x = x + jnp.concatenate([mix, att], axis=-1) @ w_out[i]
        x = x + 0.5 * swiglu(rms_norm(x, ffn2_norm[i]), ffn2_w_gu[i], ffn2_w_down[i])
    return rms_norm(x, final_norm)
```

```cpp
#include <hip/hip_runtime.h>
#include <hip/hip_cooperative_groups.h>
#include <cstdio>
#include <cstdint>
namespace cg = cooperative_groups;
#ifndef PROBE
#define PROBE 0
#endif
#ifndef K_ALIGN
#define K_ALIGN true
#endif
#ifndef RELAX_EPI
#define RELAX_EPI false
#endif
#ifndef USE_PRE
#define USE_PRE true
#endif
#ifndef K_SP2_RESID
#define K_SP2_RESID K_SP2
#endif
#ifndef PG8_WGM
#define PG8_WGM 8
#endif
#ifndef K_SP2
#define K_SP2 true
#endif
namespace pg8 {
#define PG8_LAS __attribute__((address_space(3)))
typedef unsigned short bf16_t;
typedef short bf16x8 __attribute__((ext_vector_type(8)));
typedef float f32x4 __attribute__((ext_vector_type(4)));
typedef unsigned u32x4 __attribute__((ext_vector_type(4)));
typedef int v4i_t __attribute__((ext_vector_type(4)));
typedef unsigned u32x2 __attribute__((ext_vector_type(2)));
constexpr int BM = 256, BK = 64, HALF = 128, HTB = HALF * BK * 2  , STAGE_BYTES = 8 * HTB, NXCD = 8, WGM = PG8_WGM;

__host__ __device__ __forceinline__ int lds_byte(int r, int c) { const int st = (r >> 4) * 2 + (c >> 5), rr = r & 15, cc = c & 31, ob = rr * 64 + cc * 2; return st * 1024 + (ob ^ (((ob >> 9) & 1) << 5)); }
__host__ __device__ __forceinline__ void stage_rc(int b, int& R, int& C) { const int st = b / 1024, sb = b % 1024, swz = sb ^ (((sb >> 9) & 1) << 5); R = (st >> 1) * 16 + swz / 64; C = (st & 1) * 32 + (swz % 64) / 2; }
__host__ __device__ __forceinline__ int perm32(int rho) { const int n = rho >> 4, i = rho & 15; return 8 * (i >> 2) + 4 * n + (i & 3); }

struct Unit { int pm, pn; };
struct Gemm { const bf16_t* A; const bf16_t* Bt; int M, N, K; };

struct StaticOrder {
    int nM, nN, nwg, G, c;
    __host__ __device__ void init(int M, int N, int G_, int c_) { nM = M / BM; nN = N / BM; nwg = nM * nN; G = G_; c = c_; }
    __host__ __device__ bool next(int i, Unit& u) const {
        const long L = (long)i * G + c; if (L >= nwg) return false;
        int wgid = (int)L; { const int q = nwg / NXCD, r = nwg % NXCD, xcd = wgid % NXCD, off = wgid / NXCD; wgid = (xcd < r ? xcd * (q + 1) : r * (q + 1) + (xcd - r) * q) + off; }
        const int nig = WGM * nN, gid = wgid / nig, fm = gid * WGM, gsz = (nM - fm) < WGM ? (nM - fm) : WGM;
        u.pm = fm + ((wgid % nig) % gsz); u.pn = (wgid % nig) / gsz; return true;
    }
    __device__ __forceinline__ void a_ready(const Unit&) const {}
    __device__ __forceinline__ void done(const Unit&) const {}
};

__device__ __forceinline__ unsigned cvt_pk_bf16(float lo, float hi) { unsigned r; asm volatile("v_cvt_pk_bf16_f32 %0, %1, %2" : "=v"(r) : "v"(lo), "v"(hi)); return r; }
typedef float f32x2 __attribute__((ext_vector_type(2)));
constexpr float RMS_EPS = 1e-6f;
constexpr float SSQ_FX = 1024.0f;
__device__ __forceinline__ float rstd_from_bits(unsigned bits) { return __builtin_amdgcn_rsqf((float)bits * (1.0f / (1024.0f * SSQ_FX)) + RMS_EPS); }
__device__ __forceinline__ float rstd_of(const float* ssq, int row) { return rstd_from_bits(((const unsigned*)ssq)[row]); }

template <bool OUT8, bool IN8 = false> struct EpiSwigluT {
    static constexpr bool FP8 = IN8, PERM = true, AFTER_DRAIN = false, PRE = USE_PRE; static constexpr int NST = 8;
    bf16_t* O; const float* ssq; int ldo;
    __device__ __forceinline__ void operator()(const f32x4 (&acc)[2][2][4][2], const Unit& u, int wr, int wc, int fr, int fq, const PG8_LAS float* rs) const {
        const int row0 = u.pm * BM + wr * 64 + fr, col0 = u.pn * HALF + wc * 32 + 8 * fq;
        float rr[2][4];
#pragma unroll
        for (int ai = 0; ai < 2; ++ai)
#pragma unroll
            for (int m = 0; m < 4; ++m) rr[ai][m] = USE_PRE ? rs[wr * 64 + fr + ai * HALF + m * 16] : rstd_of(ssq, row0 + ai * HALF + m * 16);
#pragma unroll
        for (int ai = 0; ai < 2; ++ai)
#pragma unroll
            for (int m = 0; m < 4; ++m) {
                const int row = row0 + ai * HALF + m * 16;
                const float r = IN8 ? rr[ai][m] * (1.0f / 32.0f) : rr[ai][m];
                const float k1 = -1.4426950408889634f * r, r2 = r * r;
                unsigned w[4]; f32x2 hh[2][2];
#pragma unroll
                for (int n = 0; n < 2; ++n)
#pragma unroll
                    for (int j = 0; j < 2; ++j) {
                        const f32x2 gg = (f32x2){acc[ai][0][m][n][2 * j], acc[ai][0][m][n][2 * j + 1]}, uu = (f32x2){acc[ai][1][m][n][2 * j], acc[ai][1][m][n][2 * j + 1]};
                        const f32x2 x = gg * k1; f32x2 ex; ex.x = __builtin_amdgcn_exp2f(x.x); ex.y = __builtin_amdgcn_exp2f(x.y);
                        const f32x2 d = ex + 1.0f; f32x2 q; q.x = __builtin_amdgcn_rcpf(d.x); q.y = __builtin_amdgcn_rcpf(d.y);
                        const f32x2 h = ((gg * uu) * r2) * q;
                        if constexpr (!OUT8) w[2 * n + j] = cvt_pk_bf16(h.x, h.y);
                        else hh[n][j] = h;
                    }
                if constexpr (OUT8) {
#pragma unroll
                    for (int n = 0; n < 2; ++n) { int p = __builtin_amdgcn_cvt_pk_fp8_f32(hh[n][0].x, hh[n][0].y, 0, false); p = __builtin_amdgcn_cvt_pk_fp8_f32(hh[n][1].x, hh[n][1].y, p, true); w[n] = (unsigned)p; } }
                if constexpr (!OUT8) __builtin_nontemporal_store((u32x4){w[0], w[1], w[2], w[3]}, (u32x4*)(O + (size_t)row * ldo + col0));
                else __builtin_nontemporal_store((u32x2){w[0], w[1]}, (u32x2*)((unsigned char*)O + (size_t)row * ldo + col0));
            }
    }
};
template <bool IN8, long X8D = 0> struct EpiResidT {
    static constexpr bool FP8 = IN8, PERM = true, AFTER_DRAIN = false, PRE = false; static constexpr int NST = 24;
    const float* xin; bf16_t* xb; float* ssq; float s;
    __device__ __forceinline__ void finish_row(const f32x4 (&v)[2][2], int row, int col0, int fq) const {
        float sq = 0.f;
#pragma unroll
        for (int bj = 0; bj < 2; ++bj) {
            const f32x4 v0 = v[bj][0], v1 = v[bj][1];
            u32x4 w; w.x = cvt_pk_bf16(v0[0], v0[1]); w.y = cvt_pk_bf16(v0[2], v0[3]); w.z = cvt_pk_bf16(v1[0], v1[1]); w.w = cvt_pk_bf16(v1[2], v1[3]);
            *(u32x4*)(xb + (size_t)row * 1024 + col0 + bj * HALF) = w;
            if constexpr (X8D != 0) { int p0 = __builtin_amdgcn_cvt_pk_fp8_f32(v0[0], v0[1], 0, false); p0 = __builtin_amdgcn_cvt_pk_fp8_f32(v0[2], v0[3], p0, true);
                int p1 = __builtin_amdgcn_cvt_pk_fp8_f32(v1[0], v1[1], 0, false); p1 = __builtin_amdgcn_cvt_pk_fp8_f32(v1[2], v1[3], p1, true);
                *(u32x2*)((unsigned char*)xb + X8D + (size_t)row * 1024 + col0 + bj * HALF) = (u32x2){(unsigned)p0, (unsigned)p1}; }
            sq += (v0[0] * v0[0] + v0[1] * v0[1]) + (v0[2] * v0[2] + v0[3] * v0[3]) + (v1[0] * v1[0] + v1[1] * v1[1]) + (v1[2] * v1[2] + v1[3] * v1[3]);
        }
        sq += __shfl_xor(sq, 16); sq += __shfl_xor(sq, 32);
        if (fq == 0) (void)__hip_atomic_fetch_add((unsigned*)ssq + row, (unsigned)(sq * SSQ_FX + 0.5f), __ATOMIC_RELAXED, __HIP_MEMORY_SCOPE_AGENT);
    }
    __device__ __forceinline__ void operator()(const f32x4 (&acc)[2][2][4][2], const Unit& u, int wr, int wc, int fr, int fq, const PG8_LAS float*) const {
        const int row0 = u.pm * BM + wr * 64 + fr, col0 = u.pn * BM + wc * 32 + 8 * fq;
        if (xin) {
#pragma unroll
            for (int ai = 0; ai < 2; ++ai) {
                f32x4 x[4][2][2];
#pragma unroll
                for (int m = 0; m < 4; ++m)
#pragma unroll
                    for (int bj = 0; bj < 2; ++bj) { const float* p = xin + (size_t)(row0 + ai * HALF + m * 16) * 1024 + col0 + bj * HALF; x[m][bj][0] = *(const f32x4*)p; x[m][bj][1] = *(const f32x4*)(p + 4); }
#pragma unroll
                for (int m = 0; m < 4; ++m) { f32x4 v[2][2];
#pragma unroll
                    for (int bj = 0; bj < 2; ++bj) { v[bj][0] = x[m][bj][0] + acc[ai][bj][m][0] * s; v[bj][1] = x[m][bj][1] + acc[ai][bj][m][1] * s; }
                    finish_row(v, row0 + ai * HALF + m * 16, col0, fq); }
            }
        } else {
            u32x4 p[2][4][2];
#pragma unroll
            for (int ai = 0; ai < 2; ++ai)
#pragma unroll
                for (int m = 0; m < 4; ++m)
#pragma unroll
                    for (int bj = 0; bj < 2; ++bj) p[ai][m][bj] = *(const u32x4*)(xb + (size_t)(row0 + ai * HALF + m * 16) * 1024 + col0 + bj * HALF);
#pragma unroll
            for (int ai = 0; ai < 2; ++ai)
#pragma unroll
                for (int m = 0; m < 4; ++m) { f32x4 v[2][2];
#pragma unroll
                    for (int bj = 0; bj < 2; ++bj) { const u32x4 q = p[ai][m][bj];
                        const f32x4 x0 = (f32x4){__uint_as_float(q.x << 16), __uint_as_float(q.x & 0xffff0000u), __uint_as_float(q.y << 16), __uint_as_float(q.y & 0xffff0000u)};
                        const f32x4 x1 = (f32x4){__uint_as_float(q.z << 16), __uint_as_float(q.z & 0xffff0000u), __uint_as_float(q.w << 16), __uint_as_float(q.w & 0xffff0000u)};
                        v[bj][0] = x0 + acc[ai][bj][m][0] * s; v[bj][1] = x1 + acc[ai][bj][m][1] * s; }
                    finish_row(v, row0 + ai * HALF + m * 16, col0, fq); }
        }
    }
};
struct EpiBf16S {
    static constexpr bool FP8 = false, PERM = true, AFTER_DRAIN = false, PRE = USE_PRE; static constexpr int NST = 16;
    bf16_t* O; int ldc; const float* ssq;
    __device__ __forceinline__ void operator()(const f32x4 (&acc)[2][2][4][2], const Unit& u, int wr, int wc, int fr, int fq, const PG8_LAS float* rs) const {
        const int row0 = u.pm * BM + wr * 64 + fr, col0 = u.pn * BM + wc * 32 + 8 * fq;
        float rr[2][4];
#pragma unroll
        for (int ai = 0; ai < 2; ++ai)
#pragma unroll
            for (int m = 0; m < 4; ++m) rr[ai][m] = USE_PRE ? rs[wr * 64 + fr + ai * HALF + m * 16] : (ssq ? rstd_of(ssq, row0 + ai * HALF + m * 16) : 1.0f);
#pragma unroll
        for (int ai = 0; ai < 2; ++ai)
#pragma unroll
            for (int m = 0; m < 4; ++m) {
                const int row = row0 + ai * HALF + m * 16;
                const float r = rr[ai][m];
#pragma unroll
                for (int bj = 0; bj < 2; ++bj) {
                    const f32x4 v0 = acc[ai][bj][m][0] * r, v1 = acc[ai][bj][m][1] * r;
                    u32x4 w; w.x = cvt_pk_bf16(v0[0], v0[1]); w.y = cvt_pk_bf16(v0[2], v0[3]); w.z = cvt_pk_bf16(v1[0], v1[1]); w.w = cvt_pk_bf16(v1[2], v1[3]);
                    *(u32x4*)(O + (size_t)row * ldc + col0 + bj * HALF) = w;
                }
            }
    }
};
struct EpiWin0 {
    static constexpr bool FP8 = false, PERM = true, AFTER_DRAIN = false, PRE = USE_PRE; static constexpr int NST = 8;
    bf16_t* O; const float* ssq;
    __device__ __forceinline__ void operator()(const f32x4 (&acc)[2][2][4][2], const Unit& u, int wr, int wc, int fr, int fq, const PG8_LAS float* rs) const {
        const int row0 = u.pm * BM + wr * 64 + fr;
        float rr[2][4];
#pragma unroll
        for (int ai = 0; ai < 2; ++ai)
#pragma unroll
            for (int m = 0; m < 4; ++m) rr[ai][m] = USE_PRE ? rs[wr * 64 + fr + ai * HALF + m * 16] : rstd_of(ssq, row0 + ai * HALF + m * 16);
        if (u.pn >= 3 && u.pn < 9) {
            const int col0 = 768 + (u.pn - 3) * HALF + wc * 32 + 8 * fq;
#pragma unroll
            for (int ai = 0; ai < 2; ++ai)
#pragma unroll
                for (int m = 0; m < 4; ++m) { const float r2 = rr[ai][m] * rr[ai][m];
                    const f32x4 v0 = acc[ai][0][m][0] * acc[ai][1][m][0] * r2, v1 = acc[ai][0][m][1] * acc[ai][1][m][1] * r2;
                    u32x4 w; w.x = cvt_pk_bf16(v0[0], v0[1]); w.y = cvt_pk_bf16(v0[2], v0[3]); w.z = cvt_pk_bf16(v1[0], v1[1]); w.w = cvt_pk_bf16(v1[2], v1[3]);
                    *(u32x4*)(O + (size_t)(row0 + ai * HALF + m * 16) * 1792 + col0) = w; }
        } else {
            const int col0 = (u.pn < 3 ? u.pn * BM : 1536) + wc * 32 + 8 * fq;
#pragma unroll
            for (int ai = 0; ai < 2; ++ai)
#pragma unroll
                for (int m = 0; m < 4; ++m) { const float r = rr[ai][m];
#pragma unroll
                    for (int bj = 0; bj < 2; ++bj) { const f32x4 v0 = acc[ai][bj][m][0] * r, v1 = acc[ai][bj][m][1] * r;
                        u32x4 w; w.x = cvt_pk_bf16(v0[0], v0[1]); w.y = cvt_pk_bf16(v0[2], v0[3]); w.z = cvt_pk_bf16(v1[0], v1[1]); w.w = cvt_pk_bf16(v1[2], v1[3]);
                        *(u32x4*)(O + (size_t)(row0 + ai * HALF + m * 16) * 1792 + col0 + bj * HALF) = w; } }
        }
    }
};
struct EpiNull {
    static constexpr bool FP8 = false, PERM = true, AFTER_DRAIN = false, PRE = false; static constexpr int NST = 0;
    float* sink;
    __device__ __forceinline__ void operator()(const f32x4 (&acc)[2][2][4][2], const Unit& u, int wr, int wc, int fr, int fq, const PG8_LAS float*) const {
        float t = 0.f;
#pragma unroll
        for (int ai = 0; ai < 2; ++ai)
#pragma unroll
            for (int bj = 0; bj < 2; ++bj)
#pragma unroll
                for (int m = 0; m < 4; ++m)
#pragma unroll
                    for (int n = 0; n < 2; ++n) t += (acc[ai][bj][m][n][0] + acc[ai][bj][m][n][1]) + (acc[ai][bj][m][n][2] + acc[ai][bj][m][n][3]);
        if (t == 123456.78125f) sink[u.pm * 256 + fr] = t;
    }
};
typedef EpiSwigluT<false> EpiSwiglu; typedef EpiSwigluT<true> EpiSwiglu8; typedef EpiSwigluT<true, true> EpiSwiglu88; typedef EpiSwigluT<false, true> EpiSwiglu08; typedef EpiResidT<false> EpiResid; typedef EpiResidT<true> EpiResid8;
template <class Epi, class Sched, bool ALIGN_EPI = false, bool SP2 = false>
__device__ __forceinline__ void gemm_phase(PG8_LAS unsigned char* lds, PG8_LAS float* rs, const Gemm g, const Sched& S, const Epi& E) {
    int tid = threadIdx.x; asm volatile("" : "+v"(tid));
    const int wid = __builtin_amdgcn_readfirstlane(tid >> 6), lane = tid & 63, wr = wid >> 2, wc = wid & 3, fr = lane & 15, fq = lane >> 4;
    const int K = g.K, nt = K / BK;
    unsigned voffA, voffB;
    { int R, C; stage_rc(tid * 16, R, C); const int Rb = Epi::PERM ? ((R & ~31) + perm32(R & 31)) : R;
        voffA = (unsigned)(R * K + C) * 2u; voffB = (unsigned)(Rb * K + C) * 2u; }
    const size_t qstep = (size_t)64 * K * 2;
    const size_t kstep = (size_t)(BK * 2);
    const size_t hstep = (size_t)HALF * K * 2;
    const size_t tstep = 2 * hstep;
    const unsigned ldsw = (unsigned)wid * 1024u;
    const int aoff = lds_byte(wr * 64 + fr, fq * 8), boff = lds_byte(wc * 32 + fr, fq * 8);
#define PG8_SA(b, h) (((b) * 2 + (h)) * HTB)
#define PG8_SB(b, h) ((4 + (b) * 2 + (h)) * HTB)
#define PG8_STAGE(bufoff, gbase, voff) do { _Pragma("unroll") for (int _i = 0; _i < 2; ++_i) \
        __builtin_amdgcn_global_load_lds((const unsigned*)((const char*)(gbase) + _i * qstep + (voff)), (PG8_LAS unsigned*)(lds + (bufoff) + ldsw + _i * 8192), 16, 0, 0); } while (0)
#define PG8_LDA(dst, b, h) do { _Pragma("unroll") for (int m = 0; m < 4; ++m) _Pragma("unroll") for (int k = 0; k < 2; ++k) dst[m][k] = *(const PG8_LAS bf16x8*)(lds + PG8_SA(b, h) + aoff + m * 2048 + k * 1024); } while (0)
#define PG8_LDB(dst, b, h) do { _Pragma("unroll") for (int n = 0; n < 2; ++n) _Pragma("unroll") for (int k = 0; k < 2; ++k) dst[n][k] = *(const PG8_LAS bf16x8*)(lds + PG8_SB(b, h) + boff + n * 2048 + k * 1024); } while (0)
#define PG8_CAT8(x, y) __builtin_shufflevector(__builtin_bit_cast(v4i_t, (x)), __builtin_bit_cast(v4i_t, (y)), 0, 1, 2, 3, 4, 5, 6, 7)
#define PG8_MMA(ai, bj, At, Bt) do { __builtin_amdgcn_s_setprio(1); \
        if constexpr (Epi::FP8) {   \
            _Pragma("unroll") for (int m = 0; m < 4; ++m) _Pragma("unroll") for (int n = 0; n < 2; ++n) \
                asm volatile("v_mfma_scale_f32_16x16x128_f8f6f4 %0, %1, %2, %0, %3, %3 op_sel_hi:[0,0,0]" : "+v"(acc[ai][bj][m][n]) : "v"(PG8_CAT8(Bt[n][0], Bt[n][1])), "v"(PG8_CAT8(At[m][0], At[m][1])), "v"(sc8));   \
        } else { \
            _Pragma("unroll") for (int m = 0; m < 4; ++m) _Pragma("unroll") for (int n = 0; n < 2; ++n) _Pragma("unroll") for (int k = 0; k < 2; ++k) \
                acc[ai][bj][m][n] = __builtin_amdgcn_mfma_f32_16x16x32_bf16(Bt[n][k], At[m][k], acc[ai][bj][m][n], 0, 0, 0); } \
        __builtin_amdgcn_s_setprio(0); } while (0)
#define PG8_WAIT_V(n) asm volatile("s_waitcnt vmcnt(" #n ")" ::: "memory")
#define PG8_WAIT_VN(N) asm volatile("s_waitcnt vmcnt(%0)" :: "n"(N) : "memory")
#define PG8_WAIT_L(n) asm volatile("s_waitcnt lgkmcnt(" #n ")" ::: "memory")
#define PG8_BAR __builtin_amdgcn_s_barrier()
#define PG8_SCHED __builtin_amdgcn_sched_barrier(0)
    Unit cur, nxt; int ui = 0;
    if (!S.next(0, cur)) return;
    f32x4 acc[2][2][4][2];
#pragma unroll
    for (int a = 0; a < 2; ++a)
#pragma unroll
        for (int b = 0; b < 2; ++b)
#pragma unroll
            for (int m = 0; m < 4; ++m)
#pragma unroll
                for (int n = 0; n < 2; ++n) acc[a][b][m][n] = (f32x4){0.f, 0.f, 0.f, 0.f};
    bf16x8 At[4][2], B0[2][2], B1[2][2];
    const unsigned sc8 = 0x7f7f7f7fu; (void)sc8;
    const char* cA = (const char*)g.A + (size_t)cur.pm * tstep; const char* cB = (const char*)g.Bt + (size_t)cur.pn * tstep;
    S.a_ready(cur);
    float pre = 1.0f;
#define PG8_PRELOAD(u) do { if constexpr (Epi::PRE) { if (E.ssq) { const float* _p = E.ssq + (u).pm * BM + (tid & (BM - 1)); asm volatile("global_load_dword %0, %1, off" : "=v"(pre) : "v"(_p) : "memory"); } } } while (0)
    PG8_PRELOAD(cur);
    if constexpr (SP2) {
        PG8_STAGE(PG8_SB(0, 0), cB, voffB); PG8_STAGE(PG8_SB(0, 1), cB + hstep, voffB); PG8_STAGE(PG8_SA(0, 0), cA, voffA); PG8_STAGE(PG8_SA(0, 1), cA + hstep, voffA);
        if (wr == 1) PG8_BAR;
        PG8_WAIT_V(2); PG8_BAR;
        PG8_STAGE(PG8_SB(1, 0), cB + kstep, voffB); PG8_STAGE(PG8_SA(1, 0), cA + kstep, voffA); PG8_STAGE(PG8_SB(1, 1), cB + hstep + kstep, voffB);
        PG8_WAIT_V(6); PG8_BAR;
    } else {
        PG8_STAGE(PG8_SB(0, 0), cB, voffB); PG8_STAGE(PG8_SA(0, 0), cA, voffA); PG8_STAGE(PG8_SB(0, 1), cB + hstep, voffB); PG8_STAGE(PG8_SA(0, 1), cA + hstep, voffA);
        if (wr == 1) PG8_BAR;
        PG8_WAIT_V(4); PG8_BAR;
        PG8_STAGE(PG8_SB(1, 0), cB + kstep, voffB); PG8_STAGE(PG8_SA(1, 0), cA + kstep, voffA); PG8_STAGE(PG8_SB(1, 1), cB + hstep + kstep, voffB);
        PG8_WAIT_V(6); PG8_BAR;
    }
    for (;;) {
        const bool has_next = S.next(ui + 1, nxt);
        const char* nA = has_next ? (const char*)g.A + (size_t)nxt.pm * tstep : cA; const char* nB = has_next ? (const char*)g.Bt + (size_t)nxt.pn * tstep : cB;
        for (int t = 0; t < nt; t += 2) {
            const bool last = (t == nt - 2);
            const bool relax = RELAX_EPI && (t == 0) && (ui > 0);
            const char* a1 = cA + (size_t)(t + 1) * kstep;
            const char* a2 = last ? nA : cA + (size_t)(t + 2) * kstep; const char* b2 = last ? nB : cB + (size_t)(t + 2) * kstep;
            const char* a3 = a2 + kstep; const char* b3 = b2 + kstep;
            if (last && has_next) S.a_ready(nxt);
            if constexpr (SP2) {
            PG8_LDB(B0, 0, 0); PG8_LDB(B1, 0, 1); PG8_SCHED; PG8_LDA(At, 0, 0); PG8_STAGE(PG8_SA(1, 1), a1 + hstep, voffA);
            if (relax) PG8_WAIT_VN(8 + Epi::NST); else PG8_WAIT_V(8); PG8_WAIT_L(0); PG8_BAR; PG8_MMA(0, 0, At, B0); PG8_MMA(0, 1, At, B1); PG8_BAR; PG8_SCHED;
            PG8_LDA(At, 0, 1); PG8_STAGE(PG8_SB(0, 0), b2, voffB); PG8_STAGE(PG8_SB(0, 1), b2 + hstep, voffB); PG8_STAGE(PG8_SA(0, 0), a2, voffA);
            if (relax) PG8_WAIT_VN(8 + Epi::NST); else PG8_WAIT_V(8); PG8_WAIT_L(0); PG8_BAR; PG8_MMA(1, 0, At, B0); PG8_MMA(1, 1, At, B1); PG8_BAR; PG8_SCHED;
            PG8_LDB(B0, 1, 0); PG8_LDB(B1, 1, 1); PG8_SCHED; PG8_LDA(At, 1, 0); PG8_STAGE(PG8_SA(0, 1), a2 + hstep, voffA);
            PG8_WAIT_V(8); PG8_WAIT_L(0); PG8_BAR; PG8_MMA(0, 0, At, B0); PG8_MMA(0, 1, At, B1); PG8_BAR; PG8_SCHED;
            PG8_LDA(At, 1, 1); PG8_STAGE(PG8_SB(1, 0), b3, voffB); PG8_STAGE(PG8_SB(1, 1), b3 + hstep, voffB); PG8_STAGE(PG8_SA(1, 0), a3, voffA);
            PG8_WAIT_V(8); PG8_WAIT_L(0); PG8_BAR; PG8_MMA(1, 0, At, B0); PG8_MMA(1, 1, At, B1); PG8_BAR; PG8_SCHED;
            } else {
            PG8_LDB(B0, 0, 0); PG8_SCHED; PG8_LDA(At, 0, 0); PG8_STAGE(PG8_SA(1, 1), a1 + hstep, voffA);
            PG8_WAIT_L(8); PG8_BAR; PG8_WAIT_L(0); PG8_MMA(0, 0, At, B0); PG8_BAR; PG8_SCHED;
            PG8_LDB(B1, 0, 1); PG8_STAGE(PG8_SB(0, 0), b2, voffB);
            PG8_BAR; PG8_WAIT_L(0); PG8_MMA(0, 1, At, B1); PG8_BAR;
            PG8_LDA(At, 0, 1); PG8_STAGE(PG8_SA(0, 0), a2, voffA);
            PG8_BAR; PG8_WAIT_L(0); PG8_MMA(1, 0, At, B0); PG8_BAR; PG8_SCHED;
            PG8_STAGE(PG8_SB(0, 1), b2 + hstep, voffB);
            PG8_WAIT_V(6); PG8_BAR; PG8_MMA(1, 1, At, B1); PG8_BAR;
            PG8_LDB(B0, 1, 0); PG8_SCHED; PG8_LDA(At, 1, 0); PG8_STAGE(PG8_SA(0, 1), a2 + hstep, voffA);
            PG8_WAIT_L(8); PG8_BAR; PG8_WAIT_L(0); PG8_MMA(0, 0, At, B0); PG8_BAR; PG8_SCHED;
            PG8_LDB(B1, 1, 1); PG8_STAGE(PG8_SB(1, 0), b3, voffB);
            PG8_BAR; PG8_WAIT_L(0); PG8_MMA(0, 1, At, B1); PG8_BAR;
            PG8_LDA(At, 1, 1); PG8_STAGE(PG8_SA(1, 0), a3, voffA);
            PG8_BAR; PG8_WAIT_L(0); PG8_MMA(1, 0, At, B0); PG8_BAR; PG8_SCHED;
            PG8_STAGE(PG8_SB(1, 1), b3 + hstep, voffB);
            PG8_WAIT_V(6); PG8_BAR; PG8_MMA(1, 1, At, B1); PG8_BAR;
            }
        }
        if constexpr (ALIGN_EPI) { if (wr == 0) PG8_BAR; }
        if constexpr (Epi::PRE) {
            if (tid < BM) rs[tid] = E.ssq ? rstd_from_bits(__float_as_uint(pre)) : 1.0f;
            PG8_WAIT_L(0); PG8_BAR; asm volatile("" ::: "memory");
        }
        if constexpr (!Epi::AFTER_DRAIN) { E(acc, cur, wr, wc, fr, fq, rs); S.done(cur); }
        if (!has_next) break;
#pragma unroll
        for (int a = 0; a < 2; ++a)
#pragma unroll
            for (int b = 0; b < 2; ++b)
#pragma unroll
                for (int m = 0; m < 4; ++m)
#pragma unroll
                    for (int n = 0; n < 2; ++n) acc[a][b][m][n] = (f32x4){0.f, 0.f, 0.f, 0.f};
        cur = nxt; cA = nA; cB = nB; ++ui;
        PG8_PRELOAD(cur);
        if constexpr (ALIGN_EPI) { if (wr == 1) PG8_BAR; }
    }
    PG8_WAIT_V(0);
    if constexpr (!ALIGN_EPI) { if (wr == 0) PG8_BAR; }
    PG8_BAR;
    if constexpr (Epi::AFTER_DRAIN) { E.fused(acc, cur, wr, wc, fr, fq, lds, wid, lane); S.done(cur); }
#undef PG8_PRELOAD
#undef PG8_SA
#undef PG8_SB
#undef PG8_STAGE
#undef PG8_LDA
#undef PG8_LDB
#undef PG8_MMA
#undef PG8_CAT8
#undef PG8_WAIT_V
#undef PG8_WAIT_L
#undef PG8_WAIT_VN
#undef PG8_BAR
#undef PG8_SCHED
}
}
constexpr int NWAVES = 8;
#ifndef F8MASK
#define F8MASK 8
#endif
constexpr int F8_DOWN = F8MASK;
#ifndef F8GU
#define F8GU 8
#endif
constexpr int F8_GU = F8GU;
constexpr float GU8_SCALE = 32.0f;
__device__ __forceinline__ bool f8_gu(int idx) { return ((F8_GU >> idx) & 1) != 0; }
constexpr float W8_SCALE = 64.0f;
__device__ __forceinline__ bool f8_down(int idx) { return F8_DOWN == 15 ? true : (F8_DOWN == 0 ? false : ((F8_DOWN >> idx) & 1) != 0); }
constexpr int NB = 4, SEQ = 8192, D = 1024, FF = 2816, M = NB * SEQ, NMEM = 256, MW = 768, XW = 256, MROWS = NB * NMEM;
constexpr int NWIN0 = 3 * MW + XW, NWIN1 = MW + XW, PG = 192, LDZ0 = 2 * MW + XW;
constexpr size_t MiB = 1u << 20;
constexpr size_t WS_SSQ = 0;
constexpr size_t WS_BAR = 896 * 1024, BAR_ZERO_BYTES = 16 * 1024;
constexpr size_t WS_KB = 1 * MiB;
constexpr size_t WS_VT = 2 * MiB;
constexpr size_t WS_MEMN = 3 * MiB;
constexpr size_t WS_WGU = 8 * MiB, SZ_WGU = 11 * MiB;
constexpr size_t WS_WD = 52 * MiB, SZ_WD = (size_t)D * FF * 2;
constexpr size_t WS_WOUT = 74 * MiB, SZ_WOUT = 2 * MiB;
constexpr size_t WS_WKV = 78 * MiB, SZ_WKV = 1 * MiB;
constexpr size_t WS_WIN0 = 80 * MiB, WS_WIN1 = 85 * MiB;
constexpr size_t WS_XB = 88 * MiB;
constexpr size_t WS_CAT = 152 * MiB;
constexpr size_t WS_ACT = 216 * MiB;
constexpr size_t WS_XB8 = 392 * MiB;
constexpr size_t WS_END = 424 * MiB;
static_assert(WS_WD + 4 * SZ_WD <= WS_WOUT && WS_WIN0 + (size_t)NWIN0 * D * 2 <= WS_WIN1 && WS_WIN1 + 2 * MiB <= WS_XB, "ws map");
constexpr int MISC_OFF = 131072, RS_OFF = 131072 + 256, LDS_BYTES = 131072 + 256 + 1024;

#define GAS __attribute__((address_space(1)))
#define LAS __attribute__((address_space(3)))
typedef unsigned short bf16;
typedef unsigned v4u __attribute__((ext_vector_type(4)));
typedef unsigned v2u __attribute__((ext_vector_type(2)));
typedef float f32x4 __attribute__((ext_vector_type(4)));
typedef short bf16x8 __attribute__((ext_vector_type(8)));
#define LDS_WAIT() asm volatile("s_waitcnt lgkmcnt(0)" ::: "memory")
__device__ __forceinline__ unsigned pk2(float lo, float hi) { return pg8::cvt_pk_bf16(lo, hi); }
__device__ __forceinline__ float bflo(unsigned p) { return __uint_as_float(p << 16); }
__device__ __forceinline__ float bfhi(unsigned p) { return __uint_as_float(p & 0xffff0000u); }
__device__ __forceinline__ float wave_sum(float v) {
#pragma unroll
    for (int o = 1; o < 64; o <<= 1) v += __shfl_xor(v, o);
    return v;
}
#define XB_TMO      128
#define XB_XCNT(j)  (256  + 64 * (j))
#define XB_XSUB(j)  (1280 + 64 * (j))
#define XB_XGEN(j)  (2304 + 64 * (j))
#define XB_TOP      3328
#define XB_TOPGEN   3392
#define XCD_BAR_WORDS 3456
#define XB_SPIN_CAP (1u << 18)

__device__ __forceinline__ unsigned xb_ld(unsigned* p)              { return __hip_atomic_load(p, __ATOMIC_RELAXED, __HIP_MEMORY_SCOPE_AGENT); }
__device__ __forceinline__ unsigned xb_add(unsigned* p, unsigned v) { return __hip_atomic_fetch_add(p, v, __ATOMIC_RELAXED, __HIP_MEMORY_SCOPE_AGENT); }
__device__ __forceinline__ unsigned xb_xcc_id() { return (unsigned)__builtin_amdgcn_s_getreg((3 << 11) | 20) & 0xFu; }
#define XB_SPIN(cond, bar) do { unsigned _sp = 0; while (cond) { __builtin_amdgcn_s_sleep(1); \
    if ((++_sp & 255u) == 0u) { if (xb_ld(&(bar)[XB_TMO])) break; if (_sp > XB_SPIN_CAP) { atomicAdd(&(bar)[XB_TMO], 1u); break; } } } } while (0)

struct XcdBarrier {
    unsigned* bar; unsigned x;
    volatile LAS unsigned* st;
};

__device__ __forceinline__ XcdBarrier xcd_barrier_post(unsigned* bar, volatile LAS unsigned* st) {
    XcdBarrier b; b.bar = bar; b.x = xb_xcc_id(); b.st = st;
    if (threadIdx.x == 0) (void)xb_add(&bar[XB_XCNT(b.x)], 1u);
    return b;
}
__device__ __forceinline__ void xcd_barrier_complete(unsigned* bar, unsigned x, unsigned& nloc, unsigned& nx) {
    const unsigned G = gridDim.x * gridDim.y * gridDim.z;
    unsigned sum, cnt, mine, sp = 0u;
    for (;;) {
        sum = 0u; cnt = 0u; mine = 0u;
#pragma unroll
        for (unsigned j = 0; j < 16; ++j) { const unsigned c = xb_ld(&bar[XB_XCNT(j)]); sum += c; cnt += (c > 0u) ? 1u : 0u; mine = (j == x) ? c : mine; }
        if (sum == G) break;
        __builtin_amdgcn_s_sleep(1);
        if ((++sp & 255u) == 0u) { if (xb_ld(&bar[XB_TMO])) break; if (sp > XB_SPIN_CAP) { atomicAdd(&bar[XB_TMO], 1u); break; } }
    }
    nloc = mine > 0u ? mine : 1u; nx = cnt > 0u ? cnt : 1u;
}

__device__ __forceinline__ void xcd_barrier(const XcdBarrier& b) {
    asm volatile("s_waitcnt vmcnt(0)" ::: "memory");
    __syncthreads();
    if (threadIdx.x == 0) {
        unsigned* bar = b.bar;
        __builtin_amdgcn_s_waitcnt(0);
        unsigned nloc = b.st[0], nx = b.st[1];
        if (nloc == 0u) { xcd_barrier_complete(bar, b.x, nloc, nx); b.st[0] = nloc; b.st[1] = nx; }
        const unsigned old = xb_add(&bar[XB_XSUB(b.x)], 1u);
        const unsigned gen = old / nloc;
        if (old + 1u == (gen + 1u) * nloc) {
            __builtin_amdgcn_fence(__ATOMIC_RELEASE, "agent");
            asm volatile("s_waitcnt vmcnt(0)" ::: "memory");
            const unsigned og = xb_add(&bar[XB_TOP], 1u);
            const unsigned tg = og / nx;
            if (og + 1u == (tg + 1u) * nx) xb_add(&bar[XB_TOPGEN], 1u);
            else XB_SPIN(xb_ld(&bar[XB_TOPGEN]) == tg, bar);
            __builtin_amdgcn_fence(__ATOMIC_ACQUIRE, "agent");
            xb_add(&bar[XB_XGEN(b.x)], 1u);
            asm volatile("s_waitcnt vmcnt(0)" ::: "memory");
        } else {
            XB_SPIN(xb_ld(&bar[XB_XGEN(b.x)]) == gen, bar);
            __builtin_amdgcn_fence(__ATOMIC_ACQUIRE, "agent");
            asm volatile("s_waitcnt vmcnt(0)" ::: "memory");
        }
    }
    __syncthreads();
}


struct Args { const float* in[18]; float* out; unsigned char* ws; };

__device__ __forceinline__ void tr_item(const float* W, int N, const float* gain, bf16* WT, int ldk, int koff, int mode, LAS float* scr, int item, int lane, float scale8 = 0.f) {
    const int nblk = N / 32, kb = item / nblk, nb = item % nblk, k0 = 64 * kb, n0 = 32 * nb;
    f32x4 g0 = (f32x4){1.f, 1.f, 1.f, 1.f}, g1 = g0;
    if (gain) { g0 = *(const f32x4*)(gain + k0 + 8 * (lane & 7)); g1 = *(const f32x4*)(gain + k0 + 8 * (lane & 7) + 4); }
    { float v[32];
#pragma unroll
    for (int i = 0; i < 32; ++i) { const int kk = 2 * i + (lane >> 5); v[i] = __builtin_nontemporal_load(W + (size_t)(k0 + kk) * N + n0 + (lane & 31)); }
#pragma unroll
    for (int i = 0; i < 32; ++i) scr[(2 * i + (lane >> 5)) * 33 + (lane & 31)] = v[i]; }
    LDS_WAIT(); asm volatile("" ::: "memory");
    int d0 = n0;
    if (mode == 1) { const int half = n0 >= FF ? 1 : 0, j0 = n0 - half * FF; d0 = 256 * (j0 >> 7) + 128 * half + (j0 & 127); }
    if (mode == 2 && n0 >= MW && n0 < 3 * MW) { const int half = n0 >= 2 * MW ? 1 : 0, j0 = n0 - MW - half * MW; d0 = MW + 256 * (j0 >> 7) + 128 * half + (j0 & 127); }
    const int c = lane & 7;
#pragma unroll
    for (int j = 0; j < 4; ++j) { const int n = (lane >> 3) + 8 * j; const LAS float* s = scr + (8 * c) * 33 + n;
        if (scale8 != 0.f) {
            const f32x4 h0 = g0 * scale8, h1 = g1 * scale8; int lo = 0, hi = 0;
            lo = __builtin_amdgcn_cvt_pk_fp8_f32(s[0 * 33] * h0.x, s[1 * 33] * h0.y, lo, false); lo = __builtin_amdgcn_cvt_pk_fp8_f32(s[2 * 33] * h0.z, s[3 * 33] * h0.w, lo, true);
            hi = __builtin_amdgcn_cvt_pk_fp8_f32(s[4 * 33] * h1.x, s[5 * 33] * h1.y, hi, false); hi = __builtin_amdgcn_cvt_pk_fp8_f32(s[6 * 33] * h1.z, s[7 * 33] * h1.w, hi, true);
            *(v2u*)((unsigned char*)WT + (size_t)(d0 + n) * ldk + koff + k0 + 8 * c) = (v2u){(unsigned)lo, (unsigned)hi};
        } else {
        v4u o; o.x = pk2(s[0 * 33] * g0.x, s[1 * 33] * g0.y); o.y = pk2(s[2 * 33] * g0.z, s[3 * 33] * g0.w); o.z = pk2(s[4 * 33] * g1.x, s[5 * 33] * g1.y); o.w = pk2(s[6 * 33] * g1.z, s[7 * 33] * g1.w);
        *(v4u*)(WT + (size_t)(d0 + n) * ldk + koff + k0 + 8 * c) = o; } }
    LDS_WAIT(); asm volatile("" ::: "memory");
}

__device__ __forceinline__ void prologue(const Args& a, LAS unsigned char* lds, int gw, int NGW, int wave, int lane, int gtid, int NGT) {
    unsigned char* ws = a.ws;
    LAS float* scr = (LAS float*)(lds + wave * 16384);
    constexpr int I_GU = (D / 64) * (2 * FF / 32), I_D = (FF / 64) * (D / 32), I_KV = (D / 64) * (512 / 32), I_O0 = (D / 64) * (D / 32), I_O1 = (XW / 64) * (D / 32),
                  I_W0 = (D / 64) * (NWIN0 / 32), I_W1 = (D / 64) * (NWIN1 / 32), I_FOLD = 4 * (PG / 8) * (D / 64);
    constexpr int NITEMS = 4 * I_GU + 4 * I_D + 2 * I_KV + I_O0 + I_O1 + I_W0 + I_W1 + I_FOLD;
    for (int it = gw; it < NITEMS; it += NGW) {
        int r = it;
        if (r < 4 * I_GU) { const int idx = r / I_GU, l = idx >> 1, f = idx & 1; r -= idx * I_GU;
            tr_item(a.in[f ? 15 : 3] + (size_t)l * D * 2 * FF, 2 * FF, a.in[f ? 14 : 2] + l * D, (bf16*)(ws + WS_WGU + idx * SZ_WGU), D, 0, 1, scr, r, lane, f8_gu(idx) ? GU8_SCALE : 0.f); continue; }
        r -= 4 * I_GU;
        if (r < 4 * I_D) { const int idx = r / I_D, l = idx >> 1, f = idx & 1; r -= idx * I_D;
            tr_item(a.in[f ? 16 : 4] + (size_t)l * FF * D, D, nullptr, (bf16*)(ws + WS_WD + idx * SZ_WD), FF, 0, 0, scr, r, lane, f8_down(idx) ? W8_SCALE : 0.f); continue; }
        r -= 4 * I_D;
        if (r < 2 * I_KV) { const int l = r / I_KV; r -= l * I_KV;
            tr_item(a.in[7] + (size_t)l * D * 512, 512, nullptr, (bf16*)(ws + WS_WKV + l * SZ_WKV), D, 0, 0, scr, r, lane); continue; }
        r -= 2 * I_KV;
        if (r < I_O0) { tr_item(a.in[8], D, nullptr, (bf16*)(ws + WS_WOUT), D, 0, 0, scr, r, lane); continue; }
        r -= I_O0;
        if (r < I_O1) { tr_item(a.in[8] + (size_t)D * D + (size_t)MW * D, D, nullptr, (bf16*)(ws + WS_WOUT + SZ_WOUT), D, MW, 0, scr, r, lane); continue; }
        r -= I_O1;
        if (r < I_W0) { tr_item(a.in[9], NWIN0, a.in[5], (bf16*)(ws + WS_WIN0), D, 0, 2, scr, r, lane); continue; }
        r -= I_W0;
        if (r < I_W1) { tr_item(a.in[11], NWIN1, a.in[5] + D, (bf16*)(ws + WS_WIN1), D, 0, 0, scr, r, lane); continue; }
        r -= I_W1;
        {
            const int nb = r % (D / 64), kb = (r / (D / 64)) % (PG / 8), g = r / ((D / 64) * (PG / 8));
            const int n = nb * 64 + lane;
            const float* Wg = a.in[12] + (size_t)(g * PG + kb * 8) * PG;
            const float* sc = a.in[13] + g * PG;
            const float* Wo = a.in[8] + (size_t)D * D + (size_t)(g * PG) * D + n;
            float acc[8];
#pragma unroll
            for (int e = 0; e < 8; ++e) acc[e] = 0.f;
            for (int j0 = 0; j0 < PG; j0 += 8) { float wv[8];
#pragma unroll
                for (int jj = 0; jj < 8; ++jj) wv[jj] = Wo[(size_t)(j0 + jj) * D];
#pragma unroll
                for (int jj = 0; jj < 8; ++jj) wv[jj] *= sc[j0 + jj];
#pragma unroll
                for (int e = 0; e < 8; ++e)
#pragma unroll
                    for (int jj = 0; jj < 8; ++jj) acc[e] += Wg[e * PG + j0 + jj] * wv[jj]; }
            v4u o; o.x = pk2(acc[0], acc[1]); o.y = pk2(acc[2], acc[3]); o.z = pk2(acc[4], acc[5]); o.w = pk2(acc[6], acc[7]);
            *(v4u*)((bf16*)(ws + WS_WOUT + SZ_WOUT) + (size_t)n * D + g * PG + kb * 8) = o;
        }
    }
    { const float* x = a.in[0]; bf16* xb = (bf16*)(ws + WS_XB); float* ssq0 = (float*)(ws + WS_SSQ);
      for (int m0 = gw; m0 < M; m0 += 4 * NGW) {
        f32x4 v[4][4];
#pragma unroll
        for (int q = 0; q < 4; ++q) { const int m = m0 + q * NGW; const f32x4* xr = (const f32x4*)(x + (size_t)(m < M ? m : m0) * D) + lane;
#pragma unroll
            for (int j = 0; j < 4; ++j) v[q][j] = __builtin_nontemporal_load(xr + 64 * j); }
#pragma unroll
        for (int q = 0; q < 4; ++q) { const int m = m0 + q * NGW; if (m < M) { float s = 0.f;
#pragma unroll
            for (int j = 0; j < 4; ++j) s += (v[q][j].x * v[q][j].x + v[q][j].y * v[q][j].y) + (v[q][j].z * v[q][j].z + v[q][j].w * v[q][j].w);
            s = wave_sum(s);
            if (lane == 0) ((unsigned*)ssq0)[m] = (unsigned)(s * pg8::SSQ_FX + 0.5f);
            v2u* o8 = (v2u*)(xb + (size_t)m * D) + lane;
#pragma unroll
            for (int j = 0; j < 4; ++j) o8[64 * j] = (v2u){pk2(v[q][j].x, v[q][j].y), pk2(v[q][j].z, v[q][j].w)}; } }
      } }
    for (int t = gw; t < 2 * MROWS; t += NGW) { const int l = t / MROWS, m = t % MROWS;
        const f32x4* xr = (const f32x4*)(a.in[1] + (size_t)m * D) + lane; const f32x4* gr = (const f32x4*)(a.in[6] + l * D) + lane; f32x4 v[4]; float s = 0.f;
#pragma unroll
        for (int j = 0; j < 4; ++j) { v[j] = xr[64 * j]; s += (v[j].x * v[j].x + v[j].y * v[j].y) + (v[j].z * v[j].z + v[j].w * v[j].w); }
        const float r = 1.0f / sqrtf(wave_sum(s) * (1.0f / D) + pg8::RMS_EPS);
        v2u* o8 = (v2u*)((bf16*)(ws + WS_MEMN) + (size_t)t * D) + lane;
#pragma unroll
        for (int j = 0; j < 4; ++j) { const f32x4 g = gr[64 * j]; o8[64 * j] = (v2u){pk2(v[j].x * r * g.x, v[j].y * r * g.y), pk2(v[j].z * r * g.z, v[j].w * r * g.w)}; } }
    { float* z = (float*)(ws + WS_SSQ) + M; for (int i = gtid; i < 6 * M; i += NGT) z[i] = 0.f; }
}

constexpr int KROW = 144, VROW = 528, VOFF = 256 * KROW;
__device__ __forceinline__ void attn_unit(LAS unsigned char* lds, const bf16* z, int ldz, int qoff, const bf16* Kb, const bf16* Vt, bf16* cat, int b, int h, int rc0, int tid, int lane, int wave) {
    const int fr = lane & 15, fq = lane >> 4;
    bf16x8 q0[4], q1[4];
#pragma unroll
    for (int i = 0; i < 4; ++i) { const size_t row = (size_t)b * SEQ + (rc0 + (i >> 1)) * 256 + wave * 32 + (i & 1) * 16 + fr;
        const bf16* qp = z + row * ldz + qoff + h * 64 + fq * 8; q0[i] = *(const bf16x8*)qp; q1[i] = *(const bf16x8*)(qp + 32); }
    { v4u kk[4], vv[4];
#pragma unroll
      for (int q = 0; q < 4; ++q) { const int i = tid + q * 512; kk[q] = *(const v4u*)(Kb + (size_t)(b * NMEM + (i >> 3)) * 256 + h * 64 + (i & 7) * 8); vv[q] = *(const v4u*)(Vt + (size_t)(h * 64 + (i >> 5)) * MROWS + b * NMEM + (i & 31) * 8); }
#pragma unroll
      for (int q = 0; q < 4; ++q) { const int i = tid + q * 512; *(LAS v4u*)(lds + (i >> 3) * KROW + (i & 7) * 16) = kk[q]; *(LAS v4u*)(lds + VOFF + (i >> 5) * VROW + (i & 31) * 16) = vv[q]; } }
    __syncthreads();
#pragma unroll
    for (int sb = 0; sb < 4; ++sb) {
        const size_t row = (size_t)b * SEQ + (rc0 + (sb >> 1)) * 256 + wave * 32 + (sb & 1) * 16 + fr;
        f32x4 s[16];
#pragma unroll
        for (int j = 0; j < 16; ++j) {
            const bf16x8 k0 = *(const LAS bf16x8*)(lds + (16 * j + fr) * KROW + fq * 16), k1 = *(const LAS bf16x8*)(lds + (16 * j + fr) * KROW + fq * 16 + 64);
            f32x4 c = (f32x4){0.f, 0.f, 0.f, 0.f};
            c = __builtin_amdgcn_mfma_f32_16x16x32_bf16(k0, q0[sb], c, 0, 0, 0);
            s[j] = __builtin_amdgcn_mfma_f32_16x16x32_bf16(k1, q1[sb], c, 0, 0, 0);
        }
        float mx = s[0][0];
#pragma unroll
        for (int j = 0; j < 16; ++j) mx = fmaxf(fmaxf(fmaxf(mx, s[j][0]), fmaxf(s[j][1], s[j][2])), s[j][3]);
        mx = fmaxf(mx, __shfl_xor(mx, 16)); mx = fmaxf(mx, __shfl_xor(mx, 32));
        const float sc = 0.125f * 1.4426950408889634f; float sum = 0.f;
#pragma unroll
        for (int j = 0; j < 16; ++j)
#pragma unroll
            for (int i = 0; i < 4; ++i) { const float p = __builtin_amdgcn_exp2f((s[j][i] - mx) * sc); s[j][i] = p; sum += p; }
        sum += __shfl_xor(sum, 16); sum += __shfl_xor(sum, 32);
        f32x4 o[4];
#pragma unroll
        for (int c = 0; c < 4; ++c) o[c] = (f32x4){0.f, 0.f, 0.f, 0.f};
#pragma unroll
        for (int t = 0; t < 8; ++t) {
            const v4u pw = (v4u){pk2(s[2 * t][0], s[2 * t][1]), pk2(s[2 * t][2], s[2 * t][3]), pk2(s[2 * t + 1][0], s[2 * t + 1][1]), pk2(s[2 * t + 1][2], s[2 * t + 1][3])};
            const bf16x8 pb = __builtin_bit_cast(bf16x8, pw);
#pragma unroll
            for (int c = 0; c < 4; ++c) {
                const LAS unsigned char* vp = lds + VOFF + (16 * c + fr) * VROW + (32 * t + 4 * fq) * 2;
                const v2u lo = *(const LAS v2u*)vp, hi = *(const LAS v2u*)(vp + 32);
                const bf16x8 va = __builtin_bit_cast(bf16x8, (v4u){lo.x, lo.y, hi.x, hi.y});
                o[c] = __builtin_amdgcn_mfma_f32_16x16x32_bf16(va, pb, o[c], 0, 0, 0);
            }
        }
        const float inv = 1.0f / sum;
        bf16* op = cat + row * D + MW + h * 64 + 4 * fq;
#pragma unroll
        for (int c = 0; c < 4; ++c) *(v2u*)(op + 16 * c) = (v2u){pk2(o[c][0] * inv, o[c][1] * inv), pk2(o[c][2] * inv, o[c][3] * inv)};
    }
    __syncthreads();
}

#define UNPACK8(p, f) do { f[0] = bflo((p).x); f[1] = bfhi((p).x); f[2] = bflo((p).y); f[3] = bfhi((p).y); f[4] = bflo((p).z); f[5] = bfhi((p).z); f[6] = bflo((p).w); f[7] = bfhi((p).w); } while (0)
__device__ __forceinline__ void conv_mix(const bf16* z, const float* cw, bf16* cat, int gtid, int NGT) {
    for (int idx = gtid; idx < M * (MW / 8); idx += NGT) {
        const int row = idx / (MW / 8), c = idx % (MW / 8), t = row & (SEQ - 1);
        const bf16* zp = z + (size_t)row * LDZ0 + c * 8;
        const v4u pb = *(const v4u*)zp;
        v4u pu[3]; f32x4 w0[3], w1[3];
#pragma unroll
        for (int k = 0; k < 3; ++k) {
            const int dt = 2 - k, back = (t >= dt) ? dt : 0;
            pu[k] = *(const v4u*)(zp - (size_t)back * LDZ0 + MW);
            w0[k] = *(const f32x4*)(cw + k * MW + c * 8); w1[k] = *(const f32x4*)(cw + k * MW + c * 8 + 4);
        }
        float y[8], gb[8]; UNPACK8(pb, gb);
#pragma unroll
        for (int e = 0; e < 8; ++e) y[e] = 0.f;
#pragma unroll
        for (int k = 0; k < 3; ++k) {
            const float mk = (t >= 2 - k) ? 1.0f : 0.0f;
            float uu[8]; UNPACK8(pu[k], uu);
            const f32x4 a0 = w0[k] * mk, a1 = w1[k] * mk;
            y[0] += a0.x * uu[0]; y[1] += a0.y * uu[1]; y[2] += a0.z * uu[2]; y[3] += a0.w * uu[3];
            y[4] += a1.x * uu[4]; y[5] += a1.y * uu[5]; y[6] += a1.z * uu[6]; y[7] += a1.w * uu[7];
        }
        *(v4u*)(cat + (size_t)row * D + c * 8) = (v4u){pk2(gb[0] * y[0], gb[1] * y[1]), pk2(gb[2] * y[2], gb[3] * y[3]), pk2(gb[4] * y[4], gb[5] * y[5]), pk2(gb[6] * y[6], gb[7] * y[7])};
    }
}
template <int W> __device__ __forceinline__ void pool_item(const bf16* zp, int t, bf16* outp) {
    v4u p[W];
#pragma unroll
    for (int i = 0; i < W; ++i) { const int back = (i <= t) ? i : 0; p[i] = *(const v4u*)(zp - (size_t)back * NWIN1); }
    float a[8], p0[8]; UNPACK8(p[0], p0);
#pragma unroll
    for (int e = 0; e < 8; ++e) a[e] = p0[e];
#pragma unroll
    for (int i = 1; i < W; ++i) { float f[8]; UNPACK8(p[i], f); const float mk = (i <= t) ? 1.0f : 0.0f;
#pragma unroll
        for (int e = 0; e < 8; ++e) a[e] += f[e] * mk; }
    const int cnt = (t + 1) < W ? (t + 1) : W; const float ic = 1.0f / (float)cnt;
    *(v4u*)outp = (v4u){pk2(a[0] * ic - p0[0], a[1] * ic - p0[1]), pk2(a[2] * ic - p0[2], a[3] * ic - p0[3]), pk2(a[4] * ic - p0[4], a[5] * ic - p0[5]), pk2(a[6] * ic - p0[6], a[7] * ic - p0[7])};
}
__device__ __forceinline__ void pool_mix(const bf16* z, bf16* cat, int gtid, int NGT) {
    for (int idx = gtid; idx < M * (MW / 8); idx += NGT) {
        const int blk = idx / 192, rem = idx % 192, g = __builtin_amdgcn_readfirstlane(blk / (M / 8)), rb = blk % (M / 8);
        const int row = rb * 8 + rem / 24, c = g * 24 + rem % 24, t = row & (SEQ - 1);
        const bf16* zp = z + (size_t)row * NWIN1 + c * 8; bf16* op = cat + (size_t)row * D + c * 8;
        if (g == 0) pool_item<2>(zp, t, op); else if (g == 1) pool_item<4>(zp, t, op); else if (g == 2) pool_item<8>(zp, t, op); else pool_item<16>(zp, t, op);
    }
}

__global__ void __launch_bounds__(NWAVES * 64, 2) fwd_megakernel(Args a) {
    extern __shared__ __attribute__((aligned(16))) unsigned char lds_raw[];
    LAS unsigned char* lds = (LAS unsigned char*)lds_raw;
    cg::grid_group grid = cg::this_grid();
    const int G = gridDim.x, bx = blockIdx.x;
#define TID_VIEW() int tid = threadIdx.x; asm volatile("" : "+v"(tid)); const int lane = tid & 63, wave = __builtin_amdgcn_readfirstlane(tid >> 6); \
    const int gw = bx * NWAVES + wave, NGW = G * NWAVES, gtid = bx * (NWAVES * 64) + tid, NGT = G * NWAVES * 64; (void)lane; (void)gw; (void)NGW; (void)gtid; (void)NGT;
    unsigned char* ws = a.ws;
    float* ssq = (float*)(ws + WS_SSQ);
    bf16* XB = (bf16*)(ws + WS_XB); bf16* CAT = (bf16*)(ws + WS_CAT); bf16* ACT = (bf16*)(ws + WS_ACT); bf16* Z = ACT;

    if (threadIdx.x < 64) ((LAS unsigned*)(lds + MISC_OFF))[threadIdx.x] = 0u;
    __syncthreads();
    const XcdBarrier bar = xcd_barrier_post((unsigned*)(ws + WS_BAR), (volatile LAS unsigned*)(lds + MISC_OFF));
    grid.sync();
    for (int rep = 0; rep < ((PROBE & 1) ? 2 : 1); ++rep) { TID_VIEW(); prologue(a, lds, gw, NGW, wave, lane, gtid, NGT); }
    xcd_barrier(bar);

#pragma unroll 1
    for (int i = 0; i < 4; ++i) {
        const int l = i >> 1, isv = i & 1;
        const bf16* memn = (const bf16*)(ws + WS_MEMN) + (size_t)l * MROWS * D; const bf16* wkv = (const bf16*)(ws + WS_WKV + l * SZ_WKV);
        pg8::Gemm g{isv ? wkv + (size_t)256 * D : memn, isv ? memn : wkv, isv ? 256 : MROWS, isv ? MROWS : 256, D};
        pg8::StaticOrder S; S.init(g.M, g.N, G, (bx + G - 4 * i) % G);
        pg8::EpiBf16S E{isv ? (bf16*)(ws + WS_VT) + (size_t)l * 256 * MROWS : (bf16*)(ws + WS_KB) + (size_t)l * MROWS * 256, isv ? MROWS : 256, nullptr};
        pg8::gemm_phase<pg8::EpiBf16S, pg8::StaticOrder, K_ALIGN, K_SP2>(lds, (LAS float*)(lds + RS_OFF), g, S, E);
    }

#pragma unroll 1
    for (int step = 0; step < 14; ++step) {
        const int l = step / 7, s = step % 7;
        if (s == 0 || s == 5) {
            const int f = (s == 5) ? 1 : 0;
            pg8::Gemm g{XB, (const bf16*)(ws + WS_WGU + (2 * l + f) * SZ_WGU), M, 2 * FF, D};
            pg8::StaticOrder S; S.init(M, 2 * FF, G, bx);
            static_assert((F8_GU & ~F8_DOWN) == 0 && (F8_GU & 5) == 0, "an FP8 gate|up projection is only wired for FFN 2 (its e4m3 input copy comes from the W_out epilogue) and together with an FP8 down projection");
            if (f8_gu(2 * l + f)) {
                pg8::Gemm g8{(const bf16*)(ws + WS_XB8), g.Bt, M, 2 * FF, D / 2};
                pg8::EpiSwiglu88 E{ACT, ssq + (size_t)(3 * l + 2 * f) * M, FF};
                pg8::gemm_phase<pg8::EpiSwiglu88, pg8::StaticOrder, K_ALIGN, K_SP2>(lds, (LAS float*)(lds + RS_OFF), g8, S, E);
            } else if (f8_down(2 * l + f)) { pg8::EpiSwiglu8 E{ACT, ssq + (size_t)(3 * l + 2 * f) * M, FF};
                pg8::gemm_phase<pg8::EpiSwiglu8, pg8::StaticOrder, K_ALIGN, K_SP2>(lds, (LAS float*)(lds + RS_OFF), g, S, E);
            } else { pg8::EpiSwiglu E{ACT, ssq + (size_t)(3 * l + 2 * f) * M, FF};
                pg8::gemm_phase<pg8::EpiSwiglu, pg8::StaticOrder, K_ALIGN, K_SP2>(lds, (LAS float*)(lds + RS_OFF), g, S, E); }
#if (PROBE & 512)
            { struct FixedOrder : pg8::StaticOrder { __device__ bool next(int i, pg8::Unit& u) const { const long L = (long)i * G + c; if (L >= nwg) return false; u.pm = c % 8; u.pn = (c / 8) % 4; return true; } };
              FixedOrder SF; SF.init(M, 2 * FF, G, bx); pg8::EpiNull EN{(float*)(ws + 7 * MiB)}; pg8::gemm_phase<pg8::EpiNull, FixedOrder, K_ALIGN, K_SP2>(lds, (LAS float*)(lds + RS_OFF), g, SF, EN); }
#endif
#if (PROBE & 256)
            { pg8::EpiNull EN{(float*)(ws + 7 * MiB)}; pg8::gemm_phase<pg8::EpiNull, pg8::StaticOrder, K_ALIGN, K_SP2>(lds, (LAS float*)(lds + RS_OFF), g, S, EN); }
#endif
        } else if (s == 1 || s == 4 || s == 6) {
            const int f = (s == 6) ? 1 : 0; const bool isout = (s == 4);
            pg8::Gemm g{isout ? CAT : ACT, isout ? (const bf16*)(ws + WS_WOUT + l * SZ_WOUT) : (const bf16*)(ws + WS_WD + (2 * l + f) * SZ_WD), M, D, isout ? D : FF};
            pg8::StaticOrder S; S.init(M, D, G, bx);
#if (PROBE & 24)
            if (((PROBE & 8) && !isout) || ((PROBE & 16) && isout)) {
                pg8::EpiResid E0{(step == 1) ? a.in[0] : nullptr, isout ? ACT : CAT, (float*)(ws + 7 * MiB), isout ? 1.0f : 0.5f};
                pg8::gemm_phase<pg8::EpiResid, pg8::StaticOrder, K_ALIGN, K_SP2_RESID>(lds, (LAS float*)(lds + RS_OFF), g, S, E0); }
#endif
            if (!isout && f8_down(2 * l + f)) {
                pg8::Gemm g8{ACT, g.Bt, M, D, FF / 2};
                pg8::EpiResid8 E{(step == 1) ? a.in[0] : nullptr, XB, ssq + (size_t)(3 * l + 1 + 2 * f) * M, 0.5f / W8_SCALE};
                pg8::gemm_phase<pg8::EpiResid8, pg8::StaticOrder, K_ALIGN, K_SP2_RESID>(lds, (LAS float*)(lds + RS_OFF), g8, S, E);
            } else {
            if (isout && f8_gu(2 * l + 1)) {
                typedef pg8::EpiResidT<false, (long)(WS_XB8 - WS_XB)> EpiResidX8;
                EpiResidX8 E{nullptr, XB, ssq + (size_t)(3 * l + 2) * M, 1.0f};
                pg8::gemm_phase<EpiResidX8, pg8::StaticOrder, K_ALIGN, K_SP2_RESID>(lds, (LAS float*)(lds + RS_OFF), g, S, E);
            } else {
            pg8::EpiResid E{(step == 1) ? a.in[0] : nullptr, XB, ssq + (size_t)(3 * l + (isout ? 2 : 1 + 2 * f)) * M, isout ? 1.0f : 0.5f};
            pg8::gemm_phase<pg8::EpiResid, pg8::StaticOrder, K_ALIGN, K_SP2_RESID>(lds, (LAS float*)(lds + RS_OFF), g, S, E); } }
        } else if (s == 2) {
            const int N = l ? NWIN1 : NWIN0;
            pg8::Gemm g{XB, (const bf16*)(ws + (l ? WS_WIN1 : WS_WIN0)), M, N, D};
            pg8::StaticOrder S; S.init(M, N, G, bx);
            if (l == 0) { pg8::EpiWin0 E{Z, ssq + (size_t)(3 * l + 1) * M};
                pg8::gemm_phase<pg8::EpiWin0, pg8::StaticOrder, K_ALIGN, K_SP2>(lds, (LAS float*)(lds + RS_OFF), g, S, E);
            } else { pg8::EpiBf16S E{Z, N, ssq + (size_t)(3 * l + 1) * M};
                pg8::gemm_phase<pg8::EpiBf16S, pg8::StaticOrder, K_ALIGN, K_SP2>(lds, (LAS float*)(lds + RS_OFF), g, S, E); }
        } else {
            for (int rep = 0; rep < ((PROBE & 4) ? 2 : 1); ++rep) {
            TID_VIEW();
            const int ldz = l ? NWIN1 : LDZ0, qoff = l ? MW : 2 * MW;
            const bf16* Kb = (const bf16*)(ws + WS_KB) + (size_t)l * MROWS * 256; const bf16* Vt = (const bf16*)(ws + WS_VT) + (size_t)l * 256 * MROWS;
            for (int u = bx; u < NB * 4 * (SEQ / 512); u += G) { const int rp = u % (SEQ / 512), bh = u / (SEQ / 512);
                attn_unit(lds, Z, ldz, qoff, Kb, Vt, CAT, bh >> 2, bh & 3, 2 * rp, tid, lane, wave); }
            if (l == 0) conv_mix(Z, a.in[10], CAT, gtid, NGT); else pool_mix(Z, CAT, gtid, NGT);
            }
        }
        xcd_barrier(bar);
        if (PROBE & 64) xcd_barrier(bar);
    }
    for (int rep = 0; rep < ((PROBE & 128) ? 2 : 1); ++rep) { TID_VIEW(); const float* sq = ssq + (size_t)6 * M; const f32x4* gr = (const f32x4*)a.in[17] + lane * 2;
      const f32x4 g0 = gr[0], g1 = gr[1], g2 = gr[128], g3 = gr[129];
      for (int m0 = gw; m0 < M; m0 += 4 * NGW) {
        v4u p[4][2];
#pragma unroll
        for (int q = 0; q < 4; ++q) { const int m = m0 + q * NGW; const v4u* xr = (const v4u*)(XB + (size_t)(m < M ? m : m0) * D) + lane; p[q][0] = xr[0]; p[q][1] = xr[64]; }
#pragma unroll
        for (int q = 0; q < 4; ++q) { const int m = m0 + q * NGW; if (m < M) { const float r = pg8::rstd_of(sq, m); f32x4* orow = (f32x4*)(a.out + (size_t)m * D) + lane * 2;
            float f[8]; UNPACK8(p[q][0], f);
            orow[0] = (f32x4){f[0] * r * g0.x, f[1] * r * g0.y, f[2] * r * g0.z, f[3] * r * g0.w}; orow[1] = (f32x4){f[4] * r * g1.x, f[5] * r * g1.y, f[6] * r * g1.z, f[7] * r * g1.w};
            UNPACK8(p[q][1], f);
            orow[128] = (f32x4){f[0] * r * g2.x, f[1] * r * g2.y, f[2] * r * g2.z, f[3] * r * g2.w}; orow[129] = (f32x4){f[4] * r * g3.x, f[5] * r * g3.y, f[6] * r * g3.z, f[7] * r * g3.w}; } }
      } }
}

extern "C" void kernel_launch(void* const* d_in, const int* in_sizes, int n_in, void* d_out, int out_size, void* d_ws, size_t ws_size, hipStream_t stream) {
    static int grid = 0;
    if (grid == 0) {
        if (n_in != 18 || in_sizes[0] != M * D || out_size != M * D || ws_size < WS_END) { fprintf(stderr, "kernel_launch: unexpected shapes (n_in %d, in0 %d, out %d, ws %zu)\n", n_in, n_in > 0 ? in_sizes[0] : -1, out_size, ws_size); grid = -1; return; }
        int dev = 0, cus = 0, per_cu = 0;
        if (hipGetDevice(&dev) != hipSuccess || hipDeviceGetAttribute(&cus, hipDeviceAttributeMultiprocessorCount, dev) != hipSuccess) { grid = -1; return; }
        if (hipFuncSetAttribute((const void*)fwd_megakernel, hipFuncAttributeMaxDynamicSharedMemorySize, LDS_BYTES) != hipSuccess) { fprintf(stderr, "kernel_launch: hipFuncSetAttribute failed\n"); grid = -1; return; }
        if (hipOccupancyMaxActiveBlocksPerMultiprocessor(&per_cu, (const void*)fwd_megakernel, NWAVES * 64, LDS_BYTES) != hipSuccess || per_cu < 1) { fprintf(stderr, "kernel_launch: occupancy query says %d\n", per_cu); per_cu = 1; }
        (void)hipGetLastError();
        grid = cus * 1;
    }
    if (grid < 0) return;
    Args a{};
    for (int i = 0; i < 18; ++i) a.in[i] = (const float*)d_in[i];
    a.out = (float*)d_out; a.ws = (unsigned char*)d_ws;
    if (hipMemsetAsync((char*)d_ws + WS_BAR, 0, BAR_ZERO_BYTES, stream) != hipSuccess) { fprintf(stderr, "kernel_launch: memset failed\n"); return; }
    void* args[] = {&a};
    hipError_t e = hipLaunchCooperativeKernel((const void*)fwd_megakernel, dim3(grid), dim3(NWAVES * 64), args, LDS_BYTES, stream);
    if (e != hipSuccess) fprintf(stderr, "kernel_launch: cooperative launch failed: %s (grid %d)\n", hipGetErrorString(e), grid);
}
```

```cpp
#include <hip/hip_runtime.h>
#include <hip/hip_cooperative_groups.h>
#include <cstdio>
#include <cstdint>
namespace cg = cooperative_groups;
#ifndef PROBE
#define PROBE 0
#endif
#ifndef K_ALIGN
#define K_ALIGN true
#endif
#ifndef RELAX_EPI
#define RELAX_EPI false
#endif
#ifndef USE_PRE
#define USE_PRE true
#endif
#ifndef K_SP2_RESID
#define K_SP2_RESID K_SP2
#endif
#ifndef PG8_WGM
#define PG8_WGM 8
#endif
#ifndef K_SP2
#define K_SP2 true
#endif
namespace pg8 {
#define PG8_LAS __attribute__((address_space(3)))
typedef unsigned short bf16_t;
typedef short bf16x8 __attribute__((ext_vector_type(8)));
typedef float f32x4 __attribute__((ext_vector_type(4)));
typedef unsigned u32x4 __attribute__((ext_vector_type(4)));
typedef int v4i_t __attribute__((ext_vector_type(4)));
typedef unsigned u32x2 __attribute__((ext_vector_type(2)));
constexpr int BM = 256, BK = 64, HALF = 128, HTB = HALF * BK * 2  , STAGE_BYTES = 8 * HTB, NXCD = 8, WGM = PG8_WGM;

__host__ __device__ __forceinline__ int lds_byte(int r, int c) { const int st = (r >> 4) * 2 + (c >> 5), rr = r & 15, cc = c & 31, ob = rr * 64 + cc * 2; return st * 1024 + (ob ^ (((ob >> 9) & 1) << 5)); }
__host__ __device__ __forceinline__ void stage_rc(int b, int& R, int& C) { const int st = b / 1024, sb = b % 1024, swz = sb ^ (((sb >> 9) & 1) << 5); R = (st >> 1) * 16 + swz / 64; C = (st & 1) * 32 + (swz % 64) / 2; }
__host__ __device__ __forceinline__ int perm32(int rho) { const int n = rho >> 4, i = rho & 15; return 8 * (i >> 2) + 4 * n + (i & 3); }

struct Unit { int pm, pn; };
struct Gemm { const bf16_t* A; const bf16_t* Bt; int M, N, K; };

struct StaticOrder {
    int nM, nN, nwg, G, c;
    __host__ __device__ void init(int M, int N, int G_, int c_) { nM = M / BM; nN = N / BM; nwg = nM * nN; G = G_; c = c_; }
    __host__ __device__ bool next(int i, Unit& u) const {
        const long L = (long)i * G + c; if (L >= nwg) return false;
        int wgid = (int)L; { const int q = nwg / NXCD, r = nwg % NXCD, xcd = wgid % NXCD, off = wgid / NXCD; wgid = (xcd < r ? xcd * (q + 1) : r * (q + 1) + (xcd - r) * q) + off; }
        const int nig = WGM * nN, gid = wgid / nig, fm = gid * WGM, gsz = (nM - fm) < WGM ? (nM - fm) : WGM;
        u.pm = fm + ((wgid % nig) % gsz); u.pn = (wgid % nig) / gsz; return true;
    }
    __device__ __forceinline__ void a_ready(const Unit&) const {}
    __device__ __forceinline__ void done(const Unit&) const {}
};

__device__ __forceinline__ unsigned cvt_pk_bf16(float lo, float hi) { unsigned r; asm volatile("v_cvt_pk_bf16_f32 %0, %1, %2" : "=v"(r) : "v"(lo), "v"(hi)); return r; }
typedef float f32x2 __attribute__((ext_vector_type(2)));
constexpr float RMS_EPS = 1e-6f;
constexpr float SSQ_FX = 1024.0f;
__device__ __forceinline__ float rstd_from_bits(unsigned bits) { float eps = RMS_EPS; asm volatile("" : "+v"(eps));
    return __builtin_amdgcn_rsqf((float)bits * (1.0f / (1024.0f * SSQ_FX)) + eps); }
__device__ __forceinline__ float rstd_of(const float* ssq, int row) { return rstd_from_bits(((const unsigned*)ssq)[row]); }

template <bool OUT8, bool IN8 = false> struct EpiSwigluT {
    static constexpr bool FP8 = IN8, PERM = true, AFTER_DRAIN = false, PRE = USE_PRE; static constexpr int NST = 8;
    bf16_t* O; const float* ssq; int ldo;
    __device__ __forceinline__ void operator()(const f32x4 (&acc)[2][2][4][2], const Unit& u, int wr, int wc, int fr, int fq, const PG8_LAS float* rs) const {
        const int row0 = u.pm * BM + wr * 64 + fr, col0 = u.pn * HALF + wc * 32 + 8 * fq;
        float rr[2][4];
#pragma unroll
        for (int ai = 0; ai < 2; ++ai)
#pragma unroll
            for (int m = 0; m < 4; ++m) rr[ai][m] = USE_PRE ? rs[wr * 64 + fr + ai * HALF + m * 16] : rstd_of(ssq, row0 + ai * HALF + m * 16);
#pragma unroll
        for (int ai = 0; ai < 2; ++ai)
#pragma unroll
            for (int m = 0; m < 4; ++m) {
                const int row = row0 + ai * HALF + m * 16;
                const float r = IN8 ? rr[ai][m] * (1.0f / 32.0f) : rr[ai][m];
                const float k1 = -1.4426950408889634f * r, r2 = r * r;
                unsigned w[4]; f32x2 hh[2][2];
#pragma unroll
                for (int n = 0; n < 2; ++n)
#pragma unroll
                    for (int j = 0; j < 2; ++j) {
                        const f32x2 gg = (f32x2){acc[ai][0][m][n][2 * j], acc[ai][0][m][n][2 * j + 1]}, uu = (f32x2){acc[ai][1][m][n][2 * j], acc[ai][1][m][n][2 * j + 1]};
                        const f32x2 x = gg * k1; f32x2 ex; ex.x = __builtin_amdgcn_exp2f(x.x); ex.y = __builtin_amdgcn_exp2f(x.y);
                        const f32x2 d = ex + 1.0f; f32x2 q; q.x = __builtin_amdgcn_rcpf(d.x); q.y = __builtin_amdgcn_rcpf(d.y);
                        const f32x2 h = ((gg * uu) * r2) * q;
                        if constexpr (!OUT8) w[2 * n + j] = cvt_pk_bf16(h.x, h.y);
                        else hh[n][j] = h;
                    }
                if constexpr (OUT8) {
#pragma unroll
                    for (int n = 0; n < 2; ++n) { int p = __builtin_amdgcn_cvt_pk_fp8_f32(hh[n][0].x, hh[n][0].y, 0, false); p = __builtin_amdgcn_cvt_pk_fp8_f32(hh[n][1].x, hh[n][1].y, p, true); w[n] = (unsigned)p; } }
                if constexpr (!OUT8) __builtin_nontemporal_store((u32x4){w[0], w[1], w[2], w[3]}, (u32x4*)(O + (size_t)row * ldo + col0));
                else __builtin_nontemporal_store((u32x2){w[0], w[1]}, (u32x2*)((unsigned char*)O + (size_t)row * ldo + col0));
            }
    }
};
template <bool IN8, long X8D = 0> struct EpiResidT {
    static constexpr bool FP8 = IN8, PERM = true, AFTER_DRAIN = false, PRE = false; static constexpr int NST = 24;
    const float* xin; bf16_t* xb; float* ssq; float s;
    __device__ __forceinline__ void finish_row(const f32x4 (&v)[2][2], int row, int col0, int fq) const {
        float sq = 0.f;
#pragma unroll
        for (int bj = 0; bj < 2; ++bj) {
            const f32x4 v0 = v[bj][0], v1 = v[bj][1];
            u32x4 w; w.x = cvt_pk_bf16(v0[0], v0[1]); w.y = cvt_pk_bf16(v0[2], v0[3]); w.z = cvt_pk_bf16(v1[0], v1[1]); w.w = cvt_pk_bf16(v1[2], v1[3]);
            *(u32x4*)(xb + (size_t)row * 1024 + col0 + bj * HALF) = w;
            if constexpr (X8D != 0) { int p0 = __builtin_amdgcn_cvt_pk_fp8_f32(v0[0], v0[1], 0, false); p0 = __builtin_amdgcn_cvt_pk_fp8_f32(v0[2], v0[3], p0, true);
                int p1 = __builtin_amdgcn_cvt_pk_fp8_f32(v1[0], v1[1], 0, false); p1 = __builtin_amdgcn_cvt_pk_fp8_f32(v1[2], v1[3], p1, true);
                *(u32x2*)((unsigned char*)xb + X8D + (size_t)row * 1024 + col0 + bj * HALF) = (u32x2){(unsigned)p0, (unsigned)p1}; }
            sq += (v0[0] * v0[0] + v0[1] * v0[1]) + (v0[2] * v0[2] + v0[3] * v0[3]) + (v1[0] * v1[0] + v1[1] * v1[1]) + (v1[2] * v1[2] + v1[3] * v1[3]);
        }
        sq += __shfl_xor(sq, 16); sq += __shfl_xor(sq, 32);
        if (fq == 0) (void)__hip_atomic_fetch_add((unsigned*)ssq + row, (unsigned)(sq * SSQ_FX + 0.5f), __ATOMIC_RELAXED, __HIP_MEMORY_SCOPE_AGENT);
    }
    __device__ __forceinline__ void operator()(const f32x4 (&acc)[2][2][4][2], const Unit& u, int wr, int wc, int fr, int fq, const PG8_LAS float*) const {
        const int row0 = u.pm * BM + wr * 64 + fr, col0 = u.pn * BM + wc * 32 + 8 * fq;
        if (xin) {
#pragma unroll
            for (int ai = 0; ai < 2; ++ai) {
                f32x4 x[4][2][2];
#pragma unroll
                for (int m = 0; m < 4; ++m)
#pragma unroll
                    for (int bj = 0; bj < 2; ++bj) { const float* p = xin + (size_t)(row0 + ai * HALF + m * 16) * 1024 + col0 + bj * HALF; x[m][bj][0] = *(const f32x4*)p; x[m][bj][1] = *(const f32x4*)(p + 4); }
#pragma unroll
                for (int m = 0; m < 4; ++m) { f32x4 v[2][2];
#pragma unroll
                    for (int bj = 0; bj < 2; ++bj) { v[bj][0] = x[m][bj][0] + acc[ai][bj][m][0] * s; v[bj][1] = x[m][bj][1] + acc[ai][bj][m][1] * s; }
                    finish_row(v, row0 + ai * HALF + m * 16, col0, fq); }
            }
        } else {
            u32x4 p[2][4][2];
#pragma unroll
            for (int ai = 0; ai < 2; ++ai)
#pragma unroll
                for (int m = 0; m < 4; ++m)
#pragma unroll
                    for (int bj = 0; bj < 2; ++bj) p[ai][m][bj] = *(const u32x4*)(xb + (size_t)(row0 + ai * HALF + m * 16) * 1024 + col0 + bj * HALF);
#pragma unroll
            for (int ai = 0; ai < 2; ++ai)
#pragma unroll
                for (int m = 0; m < 4; ++m) { f32x4 v[2][2];
#pragma unroll
                    for (int bj = 0; bj < 2; ++bj) { const u32x4 q = p[ai][m][bj];
                        const f32x4 x0 = (f32x4){__uint_as_float(q.x << 16), __uint_as_float(q.x & 0xffff0000u), __uint_as_float(q.y << 16), __uint_as_float(q.y & 0xffff0000u)};
                        const f32x4 x1 = (f32x4){__uint_as_float(q.z << 16), __uint_as_float(q.z & 0xffff0000u), __uint_as_float(q.w << 16), __uint_as_float(q.w & 0xffff0000u)};
                        v[bj][0] = x0 + acc[ai][bj][m][0] * s; v[bj][1] = x1 + acc[ai][bj][m][1] * s; }
                    finish_row(v, row0 + ai * HALF + m * 16, col0, fq); }
        }
    }
};
struct EpiBf16S {
    static constexpr bool FP8 = false, PERM = true, AFTER_DRAIN = false, PRE = USE_PRE; static constexpr int NST = 16;
    bf16_t* O; int ldc; const float* ssq;
    __device__ __forceinline__ void operator()(const f32x4 (&acc)[2][2][4][2], const Unit& u, int wr, int wc, int fr, int fq, const PG8_LAS float* rs) const {
        const int row0 = u.pm * BM + wr * 64 + fr, col0 = u.pn * BM + wc * 32 + 8 * fq;
        float rr[2][4];
#pragma unroll
        for (int ai = 0; ai < 2; ++ai)
#pragma unroll
            for (int m = 0; m < 4; ++m) rr[ai][m] = USE_PRE ? rs[wr * 64 + fr + ai * HALF + m * 16] : (ssq ? rstd_of(ssq, row0 + ai * HALF + m * 16) : 1.0f);
#pragma unroll
        for (int ai = 0; ai < 2; ++ai)
#pragma unroll
            for (int m = 0; m < 4; ++m) {
                const int row = row0 + ai * HALF + m * 16;
                const float r = rr[ai][m];
#pragma unroll
                for (int bj = 0; bj < 2; ++bj) {
                    const f32x4 v0 = acc[ai][bj][m][0] * r, v1 = acc[ai][bj][m][1] * r;
                    u32x4 w; w.x = cvt_pk_bf16(v0[0], v0[1]); w.y = cvt_pk_bf16(v0[2], v0[3]); w.z = cvt_pk_bf16(v1[0], v1[1]); w.w = cvt_pk_bf16(v1[2], v1[3]);
                    *(u32x4*)(O + (size_t)row * ldc + col0 + bj * HALF) = w;
                }
            }
    }
};
struct EpiWin0 {
    static constexpr bool FP8 = false, PERM = true, AFTER_DRAIN = false, PRE = USE_PRE; static constexpr int NST = 8;
    bf16_t* O; const float* ssq;
    __device__ __forceinline__ void operator()(const f32x4 (&acc)[2][2][4][2], const Unit& u, int wr, int wc, int fr, int fq, const PG8_LAS float* rs) const {
        const int row0 = u.pm * BM + wr * 64 + fr;
        float rr[2][4];
#pragma unroll
        for (int ai = 0; ai < 2; ++ai)
#pragma unroll
            for (int m = 0; m < 4; ++m) rr[ai][m] = USE_PRE ? rs[wr * 64 + fr + ai * HALF + m * 16] : rstd_of(ssq, row0 + ai * HALF + m * 16);
        if (u.pn >= 3 && u.pn < 9) {
            const int col0 = 768 + (u.pn - 3) * HALF + wc * 32 + 8 * fq;
#pragma unroll
            for (int ai = 0; ai < 2; ++ai)
#pragma unroll
                for (int m = 0; m < 4; ++m) { const float r2 = rr[ai][m] * rr[ai][m];
                    const f32x4 v0 = acc[ai][0][m][0] * acc[ai][1][m][0] * r2, v1 = acc[ai][0][m][1] * acc[ai][1][m][1] * r2;
                    u32x4 w; w.x = cvt_pk_bf16(v0[0], v0[1]); w.y = cvt_pk_bf16(v0[2], v0[3]); w.z = cvt_pk_bf16(v1[0], v1[1]); w.w = cvt_pk_bf16(v1[2], v1[3]);
                    *(u32x4*)(O + (size_t)(row0 + ai * HALF + m * 16) * 1792 + col0) = w; }
        } else {
            const int col0 = (u.pn < 3 ? u.pn * BM : 1536) + wc * 32 + 8 * fq;
#pragma unroll
            for (int ai = 0; ai < 2; ++ai)
#pragma unroll
                for (int m = 0; m < 4; ++m) { const float r = rr[ai][m];
#pragma unroll
                    for (int bj = 0; bj < 2; ++bj) { const f32x4 v0 = acc[ai][bj][m][0] * r, v1 = acc[ai][bj][m][1] * r;
                        u32x4 w; w.x = cvt_pk_bf16(v0[0], v0[1]); w.y = cvt_pk_bf16(v0[2], v0[3]); w.z = cvt_pk_bf16(v1[0], v1[1]); w.w = cvt_pk_bf16(v1[2], v1[3]);
                        *(u32x4*)(O + (size_t)(row0 + ai * HALF + m * 16) * 1792 + col0 + bj * HALF) = w; } }
        }
    }
};
struct EpiNull {
    static constexpr bool FP8 = false, PERM = true, AFTER_DRAIN = false, PRE = false; static constexpr int NST = 0;
    float* sink;
    __device__ __forceinline__ void operator()(const f32x4 (&acc)[2][2][4][2], const Unit& u, int wr, int wc, int fr, int fq, const PG8_LAS float*) const {
        float t = 0.f;
#pragma unroll
        for (int ai = 0; ai < 2; ++ai)
#pragma unroll
            for (int bj = 0; bj < 2; ++bj)
#pragma unroll
                for (int m = 0; m < 4; ++m)
#pragma unroll
                    for (int n = 0; n < 2; ++n) t += (acc[ai][bj][m][n][0] + acc[ai][bj][m][n][1]) + (acc[ai][bj][m][n][2] + acc[ai][bj][m][n][3]);
        if (t == 123456.78125f) sink[u.pm * 256 + fr] = t;
    }
};
typedef EpiSwigluT<false> EpiSwiglu; typedef EpiSwigluT<true> EpiSwiglu8; typedef EpiSwigluT<true, true> EpiSwiglu88; typedef EpiSwigluT<false, true> EpiSwiglu08; typedef EpiResidT<false> EpiResid; typedef EpiResidT<true> EpiResid8;
template <class Epi, class Sched, bool ALIGN_EPI = false, bool SP2 = false>
__device__ __forceinline__ void gemm_phase(PG8_LAS unsigned char* lds, PG8_LAS float* rs, int wave0, const Gemm g, const Sched& S, const Epi& E) {
    unsigned z0_ = 0u; asm volatile("" : "+v"(z0_));
    const int tid = wave0 * 64 + (int)__builtin_amdgcn_mbcnt_hi(~0u, __builtin_amdgcn_mbcnt_lo(~0u, z0_));
    const int wid = __builtin_amdgcn_readfirstlane(tid >> 6), lane = tid & 63, wr = wid >> 2, wc = wid & 3, fr = lane & 15, fq = lane >> 4;
    const int K = g.K, nt = K / BK;
    unsigned voffA, voffB;
    { int R, C; stage_rc(tid * 16, R, C); const int Rb = Epi::PERM ? ((R & ~31) + perm32(R & 31)) : R;
        voffA = (unsigned)(R * K + C) * 2u; voffB = (unsigned)(Rb * K + C) * 2u; }
    const size_t qstep = (size_t)64 * K * 2;
    const size_t kstep = (size_t)(BK * 2);
    const size_t hstep = (size_t)HALF * K * 2;
    const size_t tstep = 2 * hstep;
    const unsigned ldsw = (unsigned)wid * 1024u;
    const int aoff = lds_byte(wr * 64 + fr, fq * 8), boff = lds_byte(wc * 32 + fr, fq * 8);
#define PG8_SA(b, h) (((b) * 2 + (h)) * HTB)
#define PG8_SB(b, h) ((4 + (b) * 2 + (h)) * HTB)
#define PG8_STAGE(bufoff, gbase, voff) do { _Pragma("unroll") for (int _i = 0; _i < 2; ++_i) \
        __builtin_amdgcn_global_load_lds((const unsigned*)((const char*)(gbase) + _i * qstep + (voff)), (PG8_LAS unsigned*)(lds + (bufoff) + ldsw + _i * 8192), 16, 0, 0); } while (0)
#define PG8_LDA(dst, b, h) do { _Pragma("unroll") for (int m = 0; m < 4; ++m) _Pragma("unroll") for (int k = 0; k < 2; ++k) dst[m][k] = *(const PG8_LAS bf16x8*)(lds + PG8_SA(b, h) + aoff + m * 2048 + k * 1024); } while (0)
#define PG8_LDB(dst, b, h) do { _Pragma("unroll") for (int n = 0; n < 2; ++n) _Pragma("unroll") for (int k = 0; k < 2; ++k) dst[n][k] = *(const PG8_LAS bf16x8*)(lds + PG8_SB(b, h) + boff + n * 2048 + k * 1024); } while (0)
#define PG8_CAT8(x, y) __builtin_shufflevector(__builtin_bit_cast(v4i_t, (x)), __builtin_bit_cast(v4i_t, (y)), 0, 1, 2, 3, 4, 5, 6, 7)
#define PG8_MMA(ai, bj, At, Bt) do { __builtin_amdgcn_s_setprio(1); \
        if constexpr (Epi::FP8) {   \
            _Pragma("unroll") for (int m = 0; m < 4; ++m) _Pragma("unroll") for (int n = 0; n < 2; ++n) \
                asm volatile("v_mfma_scale_f32_16x16x128_f8f6f4 %0, %1, %2, %0, %3, %3 op_sel_hi:[0,0,0]" : "+v"(acc[ai][bj][m][n]) : "v"(PG8_CAT8(Bt[n][0], Bt[n][1])), "v"(PG8_CAT8(At[m][0], At[m][1])), "v"(sc8));   \
        } else { \
            _Pragma("unroll") for (int m = 0; m < 4; ++m) _Pragma("unroll") for (int n = 0; n < 2; ++n) _Pragma("unroll") for (int k = 0; k < 2; ++k) \
                acc[ai][bj][m][n] = __builtin_amdgcn_mfma_f32_16x16x32_bf16(Bt[n][k], At[m][k], acc[ai][bj][m][n], 0, 0, 0); } \
        __builtin_amdgcn_s_setprio(0); } while (0)
#define PG8_WAIT_V(n) asm volatile("s_waitcnt vmcnt(" #n ")" ::: "memory")
#define PG8_WAIT_VN(N) asm volatile("s_waitcnt vmcnt(%0)" :: "n"(N) : "memory")
#define PG8_WAIT_L(n) asm volatile("s_waitcnt lgkmcnt(" #n ")" ::: "memory")
#define PG8_BAR __builtin_amdgcn_s_barrier()
#define PG8_SCHED __builtin_amdgcn_sched_barrier(0)
    Unit cur, nxt; int ui = 0;
    if (!S.next(0, cur)) return;
    f32x4 acc[2][2][4][2];
#pragma unroll
    for (int a = 0; a < 2; ++a)
#pragma unroll
        for (int b = 0; b < 2; ++b)
#pragma unroll
            for (int m = 0; m < 4; ++m)
#pragma unroll
                for (int n = 0; n < 2; ++n) acc[a][b][m][n] = (f32x4){0.f, 0.f, 0.f, 0.f};
    bf16x8 At[4][2], B0[2][2], B1[2][2];
    unsigned sc8 = 0x7f7f7f7fu; asm volatile("" : "+v"(sc8)); (void)sc8;
    const char* cA = (const char*)g.A + (size_t)cur.pm * tstep; const char* cB = (const char*)g.Bt + (size_t)cur.pn * tstep;
    S.a_ready(cur);
    float pre = 1.0f;
#define PG8_PRELOAD(u) do { if constexpr (Epi::PRE) { if (E.ssq) { const float* _p = E.ssq + (u).pm * BM + (tid & (BM - 1)); asm volatile("global_load_dword %0, %1, off" : "=v"(pre) : "v"(_p) : "memory"); } } } while (0)
    PG8_PRELOAD(cur);
    if constexpr (SP2) {
        PG8_STAGE(PG8_SB(0, 0), cB, voffB); PG8_STAGE(PG8_SB(0, 1), cB + hstep, voffB); PG8_STAGE(PG8_SA(0, 0), cA, voffA); PG8_STAGE(PG8_SA(0, 1), cA + hstep, voffA);
        if (wr == 1) PG8_BAR;
        PG8_WAIT_V(2); PG8_BAR;
        PG8_STAGE(PG8_SB(1, 0), cB + kstep, voffB); PG8_STAGE(PG8_SA(1, 0), cA + kstep, voffA); PG8_STAGE(PG8_SB(1, 1), cB + hstep + kstep, voffB);
        PG8_WAIT_V(6); PG8_BAR;
    } else {
        PG8_STAGE(PG8_SB(0, 0), cB, voffB); PG8_STAGE(PG8_SA(0, 0), cA, voffA); PG8_STAGE(PG8_SB(0, 1), cB + hstep, voffB); PG8_STAGE(PG8_SA(0, 1), cA + hstep, voffA);
        if (wr == 1) PG8_BAR;
        PG8_WAIT_V(4); PG8_BAR;
        PG8_STAGE(PG8_SB(1, 0), cB + kstep, voffB); PG8_STAGE(PG8_SA(1, 0), cA + kstep, voffA); PG8_STAGE(PG8_SB(1, 1), cB + hstep + kstep, voffB);
        PG8_WAIT_V(6); PG8_BAR;
    }
    for (;;) {
        const bool has_next = S.next(ui + 1, nxt);
        const char* nA = has_next ? (const char*)g.A + (size_t)nxt.pm * tstep : cA; const char* nB = has_next ? (const char*)g.Bt + (size_t)nxt.pn * tstep : cB;
        for (int t = 0; t < nt; t += 2) {
            const bool last = (t == nt - 2);
            const bool relax = RELAX_EPI && (t == 0) && (ui > 0);
            const char* a1 = cA + (size_t)(t + 1) * kstep;
            const char* a2 = last ? nA : cA + (size_t)(t + 2) * kstep; const char* b2 = last ? nB : cB + (size_t)(t + 2) * kstep;
            const char* a3 = a2 + kstep; const char* b3 = b2 + kstep;
            if (last && has_next) S.a_ready(nxt);
            if constexpr (SP2) {
            PG8_LDB(B0, 0, 0); PG8_LDB(B1, 0, 1); PG8_SCHED; PG8_LDA(At, 0, 0); PG8_STAGE(PG8_SA(1, 1), a1 + hstep, voffA);
            if (relax) PG8_WAIT_VN(8 + Epi::NST); else PG8_WAIT_V(8); PG8_WAIT_L(0); PG8_BAR; PG8_MMA(0, 0, At, B0); PG8_MMA(0, 1, At, B1); PG8_BAR; PG8_SCHED;
            PG8_LDA(At, 0, 1); PG8_STAGE(PG8_SB(0, 0), b2, voffB); PG8_STAGE(PG8_SB(0, 1), b2 + hstep, voffB); PG8_STAGE(PG8_SA(0, 0), a2, voffA);
            if (relax) PG8_WAIT_VN(8 + Epi::NST); else PG8_WAIT_V(8); PG8_WAIT_L(0); PG8_BAR; PG8_MMA(1, 0, At, B0); PG8_MMA(1, 1, At, B1); PG8_BAR; PG8_SCHED;
            PG8_LDB(B0, 1, 0); PG8_LDB(B1, 1, 1); PG8_SCHED; PG8_LDA(At, 1, 0); PG8_STAGE(PG8_SA(0, 1), a2 + hstep, voffA);
            PG8_WAIT_V(8); PG8_WAIT_L(0); PG8_BAR; PG8_MMA(0, 0, At, B0); PG8_MMA(0, 1, At, B1); PG8_BAR; PG8_SCHED;
            PG8_LDA(At, 1, 1); PG8_STAGE(PG8_SB(1, 0), b3, voffB); PG8_STAGE(PG8_SB(1, 1), b3 + hstep, voffB); PG8_STAGE(PG8_SA(1, 0), a3, voffA);
            PG8_WAIT_V(8); PG8_WAIT_L(0); PG8_BAR; PG8_MMA(1, 0, At, B0); PG8_MMA(1, 1, At, B1); PG8_BAR; PG8_SCHED;
            } else {
            PG8_LDB(B0, 0, 0); PG8_SCHED; PG8_LDA(At, 0, 0); PG8_STAGE(PG8_SA(1, 1), a1 + hstep, voffA);
            PG8_WAIT_L(8); PG8_BAR; PG8_WAIT_L(0); PG8_MMA(0, 0, At, B0); PG8_BAR; PG8_SCHED;
            PG8_LDB(B1, 0, 1); PG8_STAGE(PG8_SB(0, 0), b2, voffB);
            PG8_BAR; PG8_WAIT_L(0); PG8_MMA(0, 1, At, B1); PG8_BAR;
            PG8_LDA(At, 0, 1); PG8_STAGE(PG8_SA(0, 0), a2, voffA);
            PG8_BAR; PG8_WAIT_L(0); PG8_MMA(1, 0, At, B0); PG8_BAR; PG8_SCHED;
            PG8_STAGE(PG8_SB(0, 1), b2 + hstep, voffB);
            PG8_WAIT_V(6); PG8_BAR; PG8_MMA(1, 1, At, B1); PG8_BAR;
            PG8_LDB(B0, 1, 0); PG8_SCHED; PG8_LDA(At, 1, 0); PG8_STAGE(PG8_SA(0, 1), a2 + hstep, voffA);
            PG8_WAIT_L(8); PG8_BAR; PG8_WAIT_L(0); PG8_MMA(0, 0, At, B0); PG8_BAR; PG8_SCHED;
            PG8_LDB(B1, 1, 1); PG8_STAGE(PG8_SB(1, 0), b3, voffB);
            PG8_BAR; PG8_WAIT_L(0); PG8_MMA(0, 1, At, B1); PG8_BAR;
            PG8_LDA(At, 1, 1); PG8_STAGE(PG8_SA(1, 0), a3, voffA);
            PG8_BAR; PG8_WAIT_L(0); PG8_MMA(1, 0, At, B0); PG8_BAR; PG8_SCHED;
            PG8_STAGE(PG8_SB(1, 1), b3 + hstep, voffB);
            PG8_WAIT_V(6); PG8_BAR; PG8_MMA(1, 1, At, B1); PG8_BAR;
            }
        }
        if constexpr (ALIGN_EPI) { if (wr == 0) PG8_BAR; }
        if constexpr (Epi::PRE) {
            if (tid < BM) rs[tid] = E.ssq ? rstd_from_bits(__float_as_uint(pre)) : 1.0f;
            PG8_WAIT_L(0); PG8_BAR; asm volatile("" ::: "memory");
        }
        if constexpr (!Epi::AFTER_DRAIN) { E(acc, cur, wr, wc, fr, fq, rs); S.done(cur); }
        if (!has_next) break;
#pragma unroll
        for (int a = 0; a < 2; ++a)
#pragma unroll
            for (int b = 0; b < 2; ++b)
#pragma unroll
                for (int m = 0; m < 4; ++m)
#pragma unroll
                    for (int n = 0; n < 2; ++n) acc[a][b][m][n] = (f32x4){0.f, 0.f, 0.f, 0.f};
        cur = nxt; cA = nA; cB = nB; ++ui;
        PG8_PRELOAD(cur);
        if constexpr (ALIGN_EPI) { if (wr == 1) PG8_BAR; }
    }
    PG8_WAIT_V(0);
    if constexpr (!ALIGN_EPI) { if (wr == 0) PG8_BAR; }
    PG8_BAR;
    if constexpr (Epi::AFTER_DRAIN) { E.fused(acc, cur, wr, wc, fr, fq, lds, wid, lane); S.done(cur); }
#undef PG8_PRELOAD
#undef PG8_SA
#undef PG8_SB
#undef PG8_STAGE
#undef PG8_LDA
#undef PG8_LDB
#undef PG8_MMA
#undef PG8_CAT8
#undef PG8_WAIT_V
#undef PG8_WAIT_L
#undef PG8_WAIT_VN
#undef PG8_BAR
#undef PG8_SCHED
}
}
constexpr int NWAVES = 8;
#ifndef F8MASK
#define F8MASK 12
#endif
constexpr int F8_DOWN = F8MASK;
#ifndef MIX_SPLIT
#define MIX_SPLIT 35
#endif
#ifndef F8GU
#define F8GU 8
#endif
constexpr int F8_GU = F8GU;
constexpr float GU8_SCALE = 32.0f;
__device__ __forceinline__ bool f8_gu(int idx) { return ((F8_GU >> idx) & 1) != 0; }
constexpr float W8_SCALE = 64.0f;
__device__ __forceinline__ bool f8_down(int idx) { return F8_DOWN == 15 ? true : (F8_DOWN == 0 ? false : ((F8_DOWN >> idx) & 1) != 0); }
constexpr int NB = 4, SEQ = 8192, D = 1024, FF = 2816, M = NB * SEQ, NMEM = 256, MW = 768, XW = 256, MROWS = NB * NMEM;
constexpr int NWIN0 = 3 * MW + XW, NWIN1 = MW + XW, PG = 192, LDZ0 = 2 * MW + XW;
constexpr size_t MiB = 1u << 20;
constexpr size_t WS_SSQ = 0;
constexpr size_t WS_BAR = 896 * 1024, BAR_ZERO_BYTES = 16 * 1024;
constexpr size_t WS_KB = 1 * MiB;
constexpr size_t WS_VT = 2 * MiB;
constexpr size_t WS_MEMN = 3 * MiB;
constexpr size_t WS_WGU = 8 * MiB, SZ_WGU = 11 * MiB;
constexpr size_t WS_WD = 52 * MiB, SZ_WD = (size_t)D * FF * 2;
constexpr size_t WS_WOUT = 74 * MiB, SZ_WOUT = 2 * MiB;
constexpr size_t WS_WKV = 78 * MiB, SZ_WKV = 1 * MiB;
constexpr size_t WS_WIN0 = 80 * MiB, WS_WIN1 = 85 * MiB;
constexpr size_t WS_XB = 88 * MiB;
constexpr size_t WS_CAT = 152 * MiB;
constexpr size_t WS_ACT = 216 * MiB;
constexpr size_t WS_XB8 = 392 * MiB;
constexpr size_t WS_END = 424 * MiB;
static_assert(WS_WD + 4 * SZ_WD <= WS_WOUT && WS_WIN0 + (size_t)NWIN0 * D * 2 <= WS_WIN1 && WS_WIN1 + 2 * MiB <= WS_XB, "ws map");
constexpr int MISC_OFF = 131072, RS_OFF = 131072 + 256, LDS_BYTES = 131072 + 256 + 1024;

#define GAS __attribute__((address_space(1)))
#define LAS __attribute__((address_space(3)))
typedef unsigned short bf16;
typedef unsigned v4u __attribute__((ext_vector_type(4)));
typedef unsigned v2u __attribute__((ext_vector_type(2)));
typedef float f32x4 __attribute__((ext_vector_type(4)));
typedef short bf16x8 __attribute__((ext_vector_type(8)));
#define LDS_WAIT() asm volatile("s_waitcnt lgkmcnt(0)" ::: "memory")
__device__ __forceinline__ unsigned pk2(float lo, float hi) { return pg8::cvt_pk_bf16(lo, hi); }
__device__ __forceinline__ float bflo(unsigned p) { return __uint_as_float(p << 16); }
__device__ __forceinline__ float bfhi(unsigned p) { return __uint_as_float(p & 0xffff0000u); }
__device__ __forceinline__ float wave_sum(float v) {
#pragma unroll
    for (int o = 1; o < 64; o <<= 1) v += __shfl_xor(v, o);
    return v;
}
__device__ __forceinline__ int tid_from_wave(int wave0) { unsigned z_ = 0u; asm volatile("" : "+v"(z_)); return wave0 * 64 + (int)__builtin_amdgcn_mbcnt_hi(~0u, __builtin_amdgcn_mbcnt_lo(~0u, z_)); }
#define XB_TMO      128
#define XB_XCNT(j)  (256  + 64 * (j))
#define XB_XSUB(j)  (1280 + 64 * (j))
#define XB_XGEN(j)  (2304 + 64 * (j))
#define XB_TOP      3328
#define XB_TOPGEN   3392
#define XCD_BAR_WORDS 3456
#define XB_SPIN_CAP (1u << 18)

__device__ __forceinline__ unsigned xb_ld(unsigned* p)              { return __hip_atomic_load(p, __ATOMIC_RELAXED, __HIP_MEMORY_SCOPE_AGENT); }
__device__ __forceinline__ unsigned xb_add(unsigned* p, unsigned v) { return __hip_atomic_fetch_add(p, v, __ATOMIC_RELAXED, __HIP_MEMORY_SCOPE_AGENT); }
__device__ __forceinline__ unsigned xb_xcc_id() { return (unsigned)__builtin_amdgcn_s_getreg((3 << 11) | 20) & 0xFu; }
#define XB_SPIN(cond, bar) do { unsigned _sp = 0; while (cond) { __builtin_amdgcn_s_sleep(1); \
    if ((++_sp & 255u) == 0u) { if (xb_ld(&(bar)[XB_TMO])) break; if (_sp > XB_SPIN_CAP) { atomicAdd(&(bar)[XB_TMO], 1u); break; } } } } while (0)

struct XcdBarrier {
    unsigned* bar; unsigned x;
    volatile LAS unsigned* st;
};

__device__ __forceinline__ XcdBarrier xcd_barrier_post(unsigned* bar, volatile LAS unsigned* st, int tid) {
    XcdBarrier b; b.bar = bar; b.x = xb_xcc_id(); b.st = st;
    if (tid == 0) (void)xb_add(&bar[XB_XCNT(b.x)], 1u);
    return b;
}
__device__ __forceinline__ void xcd_barrier_complete(unsigned* bar, unsigned x, unsigned& nloc, unsigned& nx) {
    const unsigned G = gridDim.x * gridDim.y * gridDim.z;
    unsigned sum, cnt, mine, sp = 0u;
    for (;;) {
        sum = 0u; cnt = 0u; mine = 0u;
#pragma unroll
        for (unsigned j = 0; j < 16; ++j) { const unsigned c = xb_ld(&bar[XB_XCNT(j)]); sum += c; cnt += (c > 0u) ? 1u : 0u; mine = (j == x) ? c : mine; }
        if (sum == G) break;
        __builtin_amdgcn_s_sleep(1);
        if ((++sp & 255u) == 0u) { if (xb_ld(&bar[XB_TMO])) break; if (sp > XB_SPIN_CAP) { atomicAdd(&bar[XB_TMO], 1u); break; } }
    }
    nloc = mine > 0u ? mine : 1u; nx = cnt > 0u ? cnt : 1u;
}

__device__ __forceinline__ void xcd_barrier(const XcdBarrier& b, int wave0) {
    const int tid = tid_from_wave(wave0);
    asm volatile("s_waitcnt vmcnt(0)" ::: "memory");
    __syncthreads();
    if (tid == 0) {
        unsigned* bar = b.bar;
        __builtin_amdgcn_s_waitcnt(0);
        unsigned nloc = b.st[0], nx = b.st[1];
        if (nloc == 0u) { xcd_barrier_complete(bar, b.x, nloc, nx); b.st[0] = nloc; b.st[1] = nx; }
        const unsigned old = xb_add(&bar[XB_XSUB(b.x)], 1u);
        const unsigned gen = old / nloc;
        if (old + 1u == (gen + 1u) * nloc) {
            __builtin_amdgcn_fence(__ATOMIC_RELEASE, "agent");
            asm volatile("s_waitcnt vmcnt(0)" ::: "memory");
            const unsigned og = xb_add(&bar[XB_TOP], 1u);
            const unsigned tg = og / nx;
            if (og + 1u == (tg + 1u) * nx) xb_add(&bar[XB_TOPGEN], 1u);
            else XB_SPIN(xb_ld(&bar[XB_TOPGEN]) == tg, bar);
            __builtin_amdgcn_fence(__ATOMIC_ACQUIRE, "agent");
            xb_add(&bar[XB_XGEN(b.x)], 1u);
            asm volatile("s_waitcnt vmcnt(0)" ::: "memory");
        } else {
            XB_SPIN(xb_ld(&bar[XB_XGEN(b.x)]) == gen, bar);
            __builtin_amdgcn_fence(__ATOMIC_ACQUIRE, "agent");
            asm volatile("s_waitcnt vmcnt(0)" ::: "memory");
        }
    }
    __syncthreads();
}


struct Args { const float* in[18]; float* out; unsigned char* ws; };

__device__ __forceinline__ void tr_item(const float* W, int N, const float* gain, bf16* WT, int ldk, int koff, int mode, LAS float* scr, int item, int lane, float scale8 = 0.f) {
    const int nblk = N / 32, kb = item / nblk, nb = item % nblk, k0 = 64 * kb, n0 = 32 * nb;
    f32x4 g0 = (f32x4){1.f, 1.f, 1.f, 1.f}, g1 = g0;
    if (gain) { g0 = *(const f32x4*)(gain + k0 + 8 * (lane & 7)); g1 = *(const f32x4*)(gain + k0 + 8 * (lane & 7) + 4); }
    { float v[32];
#pragma unroll
    for (int i = 0; i < 32; ++i) { const int kk = 2 * i + (lane >> 5); v[i] = __builtin_nontemporal_load(W + (size_t)(k0 + kk) * N + n0 + (lane & 31)); }
#pragma unroll
    for (int i = 0; i < 32; ++i) scr[(2 * i + (lane >> 5)) * 33 + (lane & 31)] = v[i]; }
    LDS_WAIT(); asm volatile("" ::: "memory");
    int d0 = n0;
    if (mode == 1) { const int half = n0 >= FF ? 1 : 0, j0 = n0 - half * FF; d0 = 256 * (j0 >> 7) + 128 * half + (j0 & 127); }
    if (mode == 2 && n0 >= MW && n0 < 3 * MW) { const int half = n0 >= 2 * MW ? 1 : 0, j0 = n0 - MW - half * MW; d0 = MW + 256 * (j0 >> 7) + 128 * half + (j0 & 127); }
    const int c = lane & 7;
#pragma unroll
    for (int j = 0; j < 4; ++j) { const int n = (lane >> 3) + 8 * j; const LAS float* s = scr + (8 * c) * 33 + n;
        if (scale8 != 0.f) {
            const f32x4 h0 = g0 * scale8, h1 = g1 * scale8; int lo = 0, hi = 0;
            lo = __builtin_amdgcn_cvt_pk_fp8_f32(s[0 * 33] * h0.x, s[1 * 33] * h0.y, lo, false); lo = __builtin_amdgcn_cvt_pk_fp8_f32(s[2 * 33] * h0.z, s[3 * 33] * h0.w, lo, true);
            hi = __builtin_amdgcn_cvt_pk_fp8_f32(s[4 * 33] * h1.x, s[5 * 33] * h1.y, hi, false); hi = __builtin_amdgcn_cvt_pk_fp8_f32(s[6 * 33] * h1.z, s[7 * 33] * h1.w, hi, true);
            *(v2u*)((unsigned char*)WT + (size_t)(d0 + n) * ldk + koff + k0 + 8 * c) = (v2u){(unsigned)lo, (unsigned)hi};
        } else {
        v4u o; o.x = pk2(s[0 * 33] * g0.x, s[1 * 33] * g0.y); o.y = pk2(s[2 * 33] * g0.z, s[3 * 33] * g0.w); o.z = pk2(s[4 * 33] * g1.x, s[5 * 33] * g1.y); o.w = pk2(s[6 * 33] * g1.z, s[7 * 33] * g1.w);
        *(v4u*)(WT + (size_t)(d0 + n) * ldk + koff + k0 + 8 * c) = o; } }
    LDS_WAIT(); asm volatile("" ::: "memory");
}

__device__ __forceinline__ void prologue(const Args& a, LAS unsigned char* lds, int gw, int NGW, int wave, int lane, int gtid, int NGT) {
    unsigned char* ws = a.ws;
    LAS float* scr = (LAS float*)(lds + wave * 16384);
    constexpr int I_GU = (D / 64) * (2 * FF / 32), I_D = (FF / 64) * (D / 32), I_KV = (D / 64) * (512 / 32), I_O0 = (D / 64) * (D / 32), I_O1 = (XW / 64) * (D / 32),
                  I_W0 = (D / 64) * (NWIN0 / 32), I_W1 = (D / 64) * (NWIN1 / 32), I_FOLD = 4 * (PG / 8) * (D / 64);
    constexpr int NITEMS = 4 * I_GU + 4 * I_D + 2 * I_KV + I_O0 + I_O1 + I_W0 + I_W1 + I_FOLD;
    for (int it = gw; it < NITEMS; it += NGW) {
        int r = it;
        if (r < 4 * I_GU) { const int idx = r / I_GU, l = idx >> 1, f = idx & 1; r -= idx * I_GU;
            tr_item(a.in[f ? 15 : 3] + (size_t)l * D * 2 * FF, 2 * FF, a.in[f ? 14 : 2] + l * D, (bf16*)(ws + WS_WGU + idx * SZ_WGU), D, 0, 1, scr, r, lane, f8_gu(idx) ? GU8_SCALE : 0.f); continue; }
        r -= 4 * I_GU;
        if (r < 4 * I_D) { const int idx = r / I_D, l = idx >> 1, f = idx & 1; r -= idx * I_D;
            tr_item(a.in[f ? 16 : 4] + (size_t)l * FF * D, D, nullptr, (bf16*)(ws + WS_WD + idx * SZ_WD), FF, 0, 0, scr, r, lane, f8_down(idx) ? W8_SCALE : 0.f); continue; }
        r -= 4 * I_D;
        if (r < 2 * I_KV) { const int l = r / I_KV; r -= l * I_KV;
            tr_item(a.in[7] + (size_t)l * D * 512, 512, nullptr, (bf16*)(ws + WS_WKV + l * SZ_WKV), D, 0, 0, scr, r, lane); continue; }
        r -= 2 * I_KV;
        if (r < I_O0) { tr_item(a.in[8], D, nullptr, (bf16*)(ws + WS_WOUT), D, 0, 0, scr, r, lane); continue; }
        r -= I_O0;
        if (r < I_O1) { tr_item(a.in[8] + (size_t)D * D + (size_t)MW * D, D, nullptr, (bf16*)(ws + WS_WOUT + SZ_WOUT), D, MW, 0, scr, r, lane); continue; }
        r -= I_O1;
        if (r < I_W0) { tr_item(a.in[9], NWIN0, a.in[5], (bf16*)(ws + WS_WIN0), D, 0, 2, scr, r, lane); continue; }
        r -= I_W0;
        if (r < I_W1) { tr_item(a.in[11], NWIN1, a.in[5] + D, (bf16*)(ws + WS_WIN1), D, 0, 0, scr, r, lane); continue; }
        r -= I_W1;
        {
            const int nb = r % (D / 64), kb = (r / (D / 64)) % (PG / 8), g = r / ((D / 64) * (PG / 8));
            const int n = nb * 64 + lane;
            const float* Wg = a.in[12] + (size_t)(g * PG + kb * 8) * PG;
            const float* sc = a.in[13] + g * PG;
            const float* Wo = a.in[8] + (size_t)D * D + (size_t)(g * PG) * D + n;
            float acc[8];
#pragma unroll
            for (int e = 0; e < 8; ++e) acc[e] = 0.f;
            for (int j0 = 0; j0 < PG; j0 += 8) { float wv[8];
#pragma unroll
                for (int jj = 0; jj < 8; ++jj) wv[jj] = Wo[(size_t)(j0 + jj) * D];
#pragma unroll
                for (int jj = 0; jj < 8; ++jj) wv[jj] *= sc[j0 + jj];
#pragma unroll
                for (int e = 0; e < 8; ++e)
#pragma unroll
                    for (int jj = 0; jj < 8; ++jj) acc[e] += Wg[e * PG + j0 + jj] * wv[jj]; }
            v4u o; o.x = pk2(acc[0], acc[1]); o.y = pk2(acc[2], acc[3]); o.z = pk2(acc[4], acc[5]); o.w = pk2(acc[6], acc[7]);
            *(v4u*)((bf16*)(ws + WS_WOUT + SZ_WOUT) + (size_t)n * D + g * PG + kb * 8) = o;
        }
    }
    { const float* x = a.in[0]; bf16* xb = (bf16*)(ws + WS_XB); float* ssq0 = (float*)(ws + WS_SSQ);
      for (int m0 = gw; m0 < M; m0 += 4 * NGW) {
        f32x4 v[4][4];
#pragma unroll
        for (int q = 0; q < 4; ++q) { const int m = m0 + q * NGW; const f32x4* xr = (const f32x4*)(x + (size_t)(m < M ? m : m0) * D) + lane;
#pragma unroll
            for (int j = 0; j < 4; ++j) v[q][j] = __builtin_nontemporal_load(xr + 64 * j); }
#pragma unroll
        for (int q = 0; q < 4; ++q) { const int m = m0 + q * NGW; if (m < M) { float s = 0.f;
#pragma unroll
            for (int j = 0; j < 4; ++j) s += (v[q][j].x * v[q][j].x + v[q][j].y * v[q][j].y) + (v[q][j].z * v[q][j].z + v[q][j].w * v[q][j].w);
            s = wave_sum(s);
            if (lane == 0) ((unsigned*)ssq0)[m] = (unsigned)(s * pg8::SSQ_FX + 0.5f);
            v2u* o8 = (v2u*)(xb + (size_t)m * D) + lane;
#pragma unroll
            for (int j = 0; j < 4; ++j) o8[64 * j] = (v2u){pk2(v[q][j].x, v[q][j].y), pk2(v[q][j].z, v[q][j].w)}; } }
      } }
    for (int t = gw; t < 2 * MROWS; t += NGW) { const int l = t / MROWS, m = t % MROWS;
        const f32x4* xr = (const f32x4*)(a.in[1] + (size_t)m * D) + lane; const f32x4* gr = (const f32x4*)(a.in[6] + l * D) + lane; f32x4 v[4]; float s = 0.f;
#pragma unroll
        for (int j = 0; j < 4; ++j) { v[j] = xr[64 * j]; s += (v[j].x * v[j].x + v[j].y * v[j].y) + (v[j].z * v[j].z + v[j].w * v[j].w); }
        const float r = 1.0f / sqrtf(wave_sum(s) * (1.0f / D) + pg8::RMS_EPS);
        v2u* o8 = (v2u*)((bf16*)(ws + WS_MEMN) + (size_t)t * D) + lane;
#pragma unroll
        for (int j = 0; j < 4; ++j) { const f32x4 g = gr[64 * j]; o8[64 * j] = (v2u){pk2(v[j].x * r * g.x, v[j].y * r * g.y), pk2(v[j].z * r * g.z, v[j].w * r * g.w)}; } }
    { float* z = (float*)(ws + WS_SSQ) + M; for (int i = gtid; i < 6 * M; i += NGT) z[i] = 0.f; }
}

constexpr int KROW = 144, VROW = 528, VOFF = 256 * KROW;
__device__ __forceinline__ void attn_unit(LAS unsigned char* lds, const bf16* z, int ldz, int qoff, const bf16* Kb, const bf16* Vt, bf16* cat, int b, int h, int rc0, int tid, int lane, int wave) {
    const int fr = lane & 15, fq = lane >> 4;
    bf16x8 q0[4], q1[4];
#pragma unroll
    for (int i = 0; i < 4; ++i) { const size_t row = (size_t)b * SEQ + (rc0 + (i >> 1)) * 256 + wave * 32 + (i & 1) * 16 + fr;
        const bf16* qp = z + row * ldz + qoff + h * 64 + fq * 8; q0[i] = *(const bf16x8*)qp; q1[i] = *(const bf16x8*)(qp + 32); }
    { v4u kk[4], vv[4];
#pragma unroll
      for (int q = 0; q < 4; ++q) { const int i = tid + q * 512; kk[q] = *(const v4u*)(Kb + (size_t)(b * NMEM + (i >> 3)) * 256 + h * 64 + (i & 7) * 8); vv[q] = *(const v4u*)(Vt + (size_t)(h * 64 + (i >> 5)) * MROWS + b * NMEM + (i & 31) * 8); }
#pragma unroll
      for (int q = 0; q < 4; ++q) { const int i = tid + q * 512; *(LAS v4u*)(lds + (i >> 3) * KROW + (i & 7) * 16) = kk[q]; *(LAS v4u*)(lds + VOFF + (i >> 5) * VROW + (i & 31) * 16) = vv[q]; } }
    __syncthreads();
#pragma unroll
    for (int sb = 0; sb < 4; ++sb) {
        const size_t row = (size_t)b * SEQ + (rc0 + (sb >> 1)) * 256 + wave * 32 + (sb & 1) * 16 + fr;
        f32x4 s[16];
#pragma unroll
        for (int j = 0; j < 16; ++j) {
            const bf16x8 k0 = *(const LAS bf16x8*)(lds + (16 * j + fr) * KROW + fq * 16), k1 = *(const LAS bf16x8*)(lds + (16 * j + fr) * KROW + fq * 16 + 64);
            f32x4 c = (f32x4){0.f, 0.f, 0.f, 0.f};
            c = __builtin_amdgcn_mfma_f32_16x16x32_bf16(k0, q0[sb], c, 0, 0, 0);
            s[j] = __builtin_amdgcn_mfma_f32_16x16x32_bf16(k1, q1[sb], c, 0, 0, 0);
        }
        float mx = s[0][0];
#pragma unroll
        for (int j = 0; j < 16; ++j) mx = fmaxf(fmaxf(fmaxf(mx, s[j][0]), fmaxf(s[j][1], s[j][2])), s[j][3]);
        mx = fmaxf(mx, __shfl_xor(mx, 16)); mx = fmaxf(mx, __shfl_xor(mx, 32));
        const float sc = 0.125f * 1.4426950408889634f; float sum = 0.f;
#pragma unroll
        for (int j = 0; j < 16; ++j)
#pragma unroll
            for (int i = 0; i < 4; ++i) { const float p = __builtin_amdgcn_exp2f((s[j][i] - mx) * sc); s[j][i] = p; sum += p; }
        sum += __shfl_xor(sum, 16); sum += __shfl_xor(sum, 32);
        f32x4 o[4];
#pragma unroll
        for (int c = 0; c < 4; ++c) o[c] = (f32x4){0.f, 0.f, 0.f, 0.f};
#pragma unroll
        for (int t = 0; t < 8; ++t) {
            const v4u pw = (v4u){pk2(s[2 * t][0], s[2 * t][1]), pk2(s[2 * t][2], s[2 * t][3]), pk2(s[2 * t + 1][0], s[2 * t + 1][1]), pk2(s[2 * t + 1][2], s[2 * t + 1][3])};
            const bf16x8 pb = __builtin_bit_cast(bf16x8, pw);
#pragma unroll
            for (int c = 0; c < 4; ++c) {
                const LAS unsigned char* vp = lds + VOFF + (16 * c + fr) * VROW + (32 * t + 4 * fq) * 2;
                const v2u lo = *(const LAS v2u*)vp, hi = *(const LAS v2u*)(vp + 32);
                const bf16x8 va = __builtin_bit_cast(bf16x8, (v4u){lo.x, lo.y, hi.x, hi.y});
                o[c] = __builtin_amdgcn_mfma_f32_16x16x32_bf16(va, pb, o[c], 0, 0, 0);
            }
        }
        const float inv = 1.0f / sum;
        bf16* op = cat + row * D + MW + h * 64 + 4 * fq;
#pragma unroll
        for (int c = 0; c < 4; ++c) *(v2u*)(op + 16 * c) = (v2u){pk2(o[c][0] * inv, o[c][1] * inv), pk2(o[c][2] * inv, o[c][3] * inv)};
    }
    __syncthreads();
}

#define UNPACK8(p, f) do { f[0] = bflo((p).x); f[1] = bfhi((p).x); f[2] = bflo((p).y); f[3] = bfhi((p).y); f[4] = bflo((p).z); f[5] = bfhi((p).z); f[6] = bflo((p).w); f[7] = bfhi((p).w); } while (0)
__device__ __forceinline__ void conv_mix(const bf16* z, const float* cw, bf16* cat, int gtid, int NGT, int last = M * (MW / 8)) {
    for (int idx = gtid; idx < last; idx += NGT) {
        const int row = idx / (MW / 8), c = idx % (MW / 8), t = row & (SEQ - 1);
        const bf16* zp = z + (size_t)row * LDZ0 + c * 8;
        const v4u pb = *(const v4u*)zp;
        v4u pu[3]; f32x4 w0[3], w1[3];
#pragma unroll
        for (int k = 0; k < 3; ++k) {
            const int dt = 2 - k, back = (t >= dt) ? dt : 0;
            pu[k] = *(const v4u*)(zp - (size_t)back * LDZ0 + MW);
            w0[k] = *(const f32x4*)(cw + k * MW + c * 8); w1[k] = *(const f32x4*)(cw + k * MW + c * 8 + 4);
        }
        float y[8], gb[8]; UNPACK8(pb, gb);
#pragma unroll
        for (int e = 0; e < 8; ++e) y[e] = 0.f;
#pragma unroll
        for (int k = 0; k < 3; ++k) {
            const float mk = (t >= 2 - k) ? 1.0f : 0.0f;
            float uu[8]; UNPACK8(pu[k], uu);
            const f32x4 a0 = w0[k] * mk, a1 = w1[k] * mk;
            y[0] += a0.x * uu[0]; y[1] += a0.y * uu[1]; y[2] += a0.z * uu[2]; y[3] += a0.w * uu[3];
            y[4] += a1.x * uu[4]; y[5] += a1.y * uu[5]; y[6] += a1.z * uu[6]; y[7] += a1.w * uu[7];
        }
        *(v4u*)(cat + (size_t)row * D + c * 8) = (v4u){pk2(gb[0] * y[0], gb[1] * y[1]), pk2(gb[2] * y[2], gb[3] * y[3]), pk2(gb[4] * y[4], gb[5] * y[5]), pk2(gb[6] * y[6], gb[7] * y[7])};
    }
}
template <int W> __device__ __forceinline__ void pool_item(const bf16* zp, int t, bf16* outp) {
    v4u p[W];
#pragma unroll
    for (int i = 0; i < W; ++i) { const int back = (i <= t) ? i : 0; p[i] = *(const v4u*)(zp - (size_t)back * NWIN1); }
    float a[8], p0[8]; UNPACK8(p[0], p0);
#pragma unroll
    for (int e = 0; e < 8; ++e) a[e] = p0[e];
#pragma unroll
    for (int i = 1; i < W; ++i) { float f[8]; UNPACK8(p[i], f); const float mk = (i <= t) ? 1.0f : 0.0f;
#pragma unroll
        for (int e = 0; e < 8; ++e) a[e] += f[e] * mk; }
    const int cnt = (t + 1) < W ? (t + 1) : W; const float ic = 1.0f / (float)cnt;
    *(v4u*)outp = (v4u){pk2(a[0] * ic - p0[0], a[1] * ic - p0[1]), pk2(a[2] * ic - p0[2], a[3] * ic - p0[3]), pk2(a[4] * ic - p0[4], a[5] * ic - p0[5]), pk2(a[6] * ic - p0[6], a[7] * ic - p0[7])};
}
__device__ __forceinline__ void pool_mix(const bf16* z, bf16* cat, int gtid, int NGT, int last = M * (MW / 8)) {
    for (int idx = gtid; idx < last; idx += NGT) {
        const int blk = idx / 192, rem = idx % 192, g = __builtin_amdgcn_readfirstlane(blk / (M / 8)), rb = blk % (M / 8);
        const int row = rb * 8 + rem / 24, c = g * 24 + rem % 24, t = row & (SEQ - 1);
        const bf16* zp = z + (size_t)row * NWIN1 + c * 8; bf16* op = cat + (size_t)row * D + c * 8;
        if (g == 0) pool_item<2>(zp, t, op); else if (g == 1) pool_item<4>(zp, t, op); else if (g == 2) pool_item<8>(zp, t, op); else pool_item<16>(zp, t, op);
    }
}

__global__ void __launch_bounds__(NWAVES * 64, 2) fwd_megakernel(Args a) {
    extern __shared__ __attribute__((aligned(16))) unsigned char lds_raw[];
    LAS unsigned char* lds = (LAS unsigned char*)lds_raw;
    cg::grid_group grid = cg::this_grid();
    const int G = gridDim.x, bx = blockIdx.x;
#define TID_VIEW() int tid = tid_from_wave(wave0); const int lane = tid & 63, wave = __builtin_amdgcn_readfirstlane(tid >> 6); \
    const int gw = bx * NWAVES + wave, NGW = G * NWAVES, gtid = bx * (NWAVES * 64) + tid, NGT = G * NWAVES * 64; (void)lane; (void)gw; (void)NGW; (void)gtid; (void)NGT;
    unsigned char* ws = a.ws;
    float* ssq = (float*)(ws + WS_SSQ);
    bf16* XB = (bf16*)(ws + WS_XB); bf16* CAT = (bf16*)(ws + WS_CAT); bf16* ACT = (bf16*)(ws + WS_ACT); bf16* Z = ACT;

    const int wave0 = __builtin_amdgcn_readfirstlane((int)threadIdx.x >> 6);
    if (wave0 == 0) ((LAS unsigned*)(lds + MISC_OFF))[tid_from_wave(0)] = 0u;
    __syncthreads();
    const XcdBarrier bar = xcd_barrier_post((unsigned*)(ws + WS_BAR), (volatile LAS unsigned*)(lds + MISC_OFF), tid_from_wave(wave0));
    grid.sync();
    for (int rep = 0; rep < ((PROBE & 1) ? 2 : 1); ++rep) { TID_VIEW(); prologue(a, lds, gw, NGW, wave, lane, gtid, NGT); }
    xcd_barrier(bar, wave0);

#pragma unroll 1
    for (int i = 0; i < 4; ++i) {
        const int l = i >> 1, isv = i & 1;
        const bf16* memn = (const bf16*)(ws + WS_MEMN) + (size_t)l * MROWS * D; const bf16* wkv = (const bf16*)(ws + WS_WKV + l * SZ_WKV);
        pg8::Gemm g{isv ? wkv + (size_t)256 * D : memn, isv ? memn : wkv, isv ? 256 : MROWS, isv ? MROWS : 256, D};
        pg8::StaticOrder S; S.init(g.M, g.N, G, (bx + G - 4 * i) % G);
        pg8::EpiBf16S E{isv ? (bf16*)(ws + WS_VT) + (size_t)l * 256 * MROWS : (bf16*)(ws + WS_KB) + (size_t)l * MROWS * 256, isv ? MROWS : 256, nullptr};
        pg8::gemm_phase<pg8::EpiBf16S, pg8::StaticOrder, K_ALIGN, K_SP2>(lds, (LAS float*)(lds + RS_OFF), wave0, g, S, E);
    }

#pragma unroll 1
    for (int step = 0; step < 14; ++step) {
        const int l = step / 7, s = step % 7;
        if (s == 0 || s == 5) {
            const int f = (s == 5) ? 1 : 0;
            pg8::Gemm g{XB, (const bf16*)(ws + WS_WGU + (2 * l + f) * SZ_WGU), M, 2 * FF, D};
            pg8::StaticOrder S; S.init(M, 2 * FF, G, bx);
            static_assert((F8_GU & ~F8_DOWN) == 0 && (F8_GU & 5) == 0, "an FP8 gate|up projection is only wired for FFN 2 (its e4m3 input copy comes from the W_out epilogue) and together with an FP8 down projection");
            if (f8_gu(2 * l + f)) {
                pg8::Gemm g8{(const bf16*)(ws + WS_XB8), g.Bt, M, 2 * FF, D / 2};
                pg8::EpiSwiglu88 E{ACT, ssq + (size_t)(3 * l + 2 * f) * M, FF};
                pg8::gemm_phase<pg8::EpiSwiglu88, pg8::StaticOrder, K_ALIGN, K_SP2>(lds, (LAS float*)(lds + RS_OFF), wave0, g8, S, E);
            } else if (f8_down(2 * l + f)) { pg8::EpiSwiglu8 E{ACT, ssq + (size_t)(3 * l + 2 * f) * M, FF};
                pg8::gemm_phase<pg8::EpiSwiglu8, pg8::StaticOrder, K_ALIGN, K_SP2>(lds, (LAS float*)(lds + RS_OFF), wave0, g, S, E);
            } else { pg8::EpiSwiglu E{ACT, ssq + (size_t)(3 * l + 2 * f) * M, FF};
                pg8::gemm_phase<pg8::EpiSwiglu, pg8::StaticOrder, K_ALIGN, K_SP2>(lds, (LAS float*)(lds + RS_OFF), wave0, g, S, E); }
#if (PROBE & 512)
            { struct FixedOrder : pg8::StaticOrder { __device__ bool next(int i, pg8::Unit& u) const { const long L = (long)i * G + c; if (L >= nwg) return false; u.pm = c % 8; u.pn = (c / 8) % 4; return true; } };
              FixedOrder SF; SF.init(M, 2 * FF, G, bx); pg8::EpiNull EN{(float*)(ws + 7 * MiB)}; pg8::gemm_phase<pg8::EpiNull, FixedOrder, K_ALIGN, K_SP2>(lds, (LAS float*)(lds + RS_OFF), wave0, g, SF, EN); }
#endif
#if (PROBE & 256)
            { pg8::EpiNull EN{(float*)(ws + 7 * MiB)}; pg8::gemm_phase<pg8::EpiNull, pg8::StaticOrder, K_ALIGN, K_SP2>(lds, (LAS float*)(lds + RS_OFF), wave0, g, S, EN); }
#endif
        } else if (s == 1 || s == 4 || s == 6) {
            const int f = (s == 6) ? 1 : 0; const bool isout = (s == 4);
            pg8::Gemm g{isout ? CAT : ACT, isout ? (const bf16*)(ws + WS_WOUT + l * SZ_WOUT) : (const bf16*)(ws + WS_WD + (2 * l + f) * SZ_WD), M, D, isout ? D : FF};
            pg8::StaticOrder S; S.init(M, D, G, bx);
#if (PROBE & 24)
            if (((PROBE & 8) && !isout) || ((PROBE & 16) && isout)) {
                pg8::EpiResid E0{(step == 1) ? a.in[0] : nullptr, isout ? ACT : CAT, (float*)(ws + 7 * MiB), isout ? 1.0f : 0.5f};
                pg8::gemm_phase<pg8::EpiResid, pg8::StaticOrder, K_ALIGN, K_SP2_RESID>(lds, (LAS float*)(lds + RS_OFF), wave0, g, S, E0); }
#endif
            if (!isout && f8_down(2 * l + f)) {
                pg8::Gemm g8{ACT, g.Bt, M, D, FF / 2};
                pg8::EpiResid8 E{(step == 1) ? a.in[0] : nullptr, XB, ssq + (size_t)(3 * l + 1 + 2 * f) * M, 0.5f / W8_SCALE};
                pg8::gemm_phase<pg8::EpiResid8, pg8::StaticOrder, K_ALIGN, K_SP2_RESID>(lds, (LAS float*)(lds + RS_OFF), wave0, g8, S, E);
            } else {
            if (isout && f8_gu(2 * l + 1)) {
                typedef pg8::EpiResidT<false, (long)(WS_XB8 - WS_XB)> EpiResidX8;
                EpiResidX8 E{nullptr, XB, ssq + (size_t)(3 * l + 2) * M, 1.0f};
                pg8::gemm_phase<EpiResidX8, pg8::StaticOrder, K_ALIGN, K_SP2_RESID>(lds, (LAS float*)(lds + RS_OFF), wave0, g, S, E);
            } else {
            pg8::EpiResid E{(step == 1) ? a.in[0] : nullptr, XB, ssq + (size_t)(3 * l + (isout ? 2 : 1 + 2 * f)) * M, isout ? 1.0f : 0.5f};
            pg8::gemm_phase<pg8::EpiResid, pg8::StaticOrder, K_ALIGN, K_SP2_RESID>(lds, (LAS float*)(lds + RS_OFF), wave0, g, S, E); } }
        } else if (s == 2) {
            const int N = l ? NWIN1 : NWIN0;
            pg8::Gemm g{XB, (const bf16*)(ws + (l ? WS_WIN1 : WS_WIN0)), M, N, D};
            pg8::StaticOrder S; S.init(M, N, G, bx);
            if (l == 0) { pg8::EpiWin0 E{Z, ssq + (size_t)(3 * l + 1) * M};
                pg8::gemm_phase<pg8::EpiWin0, pg8::StaticOrder, K_ALIGN, K_SP2>(lds, (LAS float*)(lds + RS_OFF), wave0, g, S, E);
            } else { pg8::EpiBf16S E{Z, N, ssq + (size_t)(3 * l + 1) * M};
                pg8::gemm_phase<pg8::EpiBf16S, pg8::StaticOrder, K_ALIGN, K_SP2>(lds, (LAS float*)(lds + RS_OFF), wave0, g, S, E); }
        } else {
            for (int rep = 0; rep < ((PROBE & 4) ? 2 : 1); ++rep) {
            TID_VIEW();
            const int ldz = l ? NWIN1 : LDZ0, qoff = l ? MW : 2 * MW;
            const bf16* Kb = (const bf16*)(ws + WS_KB) + (size_t)l * MROWS * 256; const bf16* Vt = (const bf16*)(ws + WS_VT) + (size_t)l * 256 * MROWS;
            unsigned* ctr = (unsigned*)(ws + WS_BAR) + 4000 + 64 * l;
            volatile LAS unsigned* bc = (volatile LAS unsigned*)(lds + MISC_OFF + 64);
            constexpr int CHK = 4096, NCHK = M * (MW / 8) / CHK;
#define MIX_CHUNKS(limit) for (;;) { if (tid == 0) { unsigned one_ = 1u; asm volatile("" : "+v"(one_)); *bc = __hip_atomic_fetch_add(ctr, one_, __ATOMIC_RELAXED, __HIP_MEMORY_SCOPE_AGENT); } __syncthreads(); const int c_ = (int)*bc; __syncthreads(); \
                if (c_ >= NCHK) break; if (l == 0) conv_mix(Z, a.in[10], CAT, c_ * CHK + tid, NWAVES * 64, (c_ + 1) * CHK); else pool_mix(Z, CAT, c_ * CHK + tid, NWAVES * 64, (c_ + 1) * CHK); if (c_ >= (limit)) break; }
            if (bx & 1) { MIX_CHUNKS(MIX_SPLIT * NCHK / 100) }
            for (int u = bx; u < NB * 4 * (SEQ / 512); u += G) { const int rp = u % (SEQ / 512), bh = u / (SEQ / 512);
                attn_unit(lds, Z, ldz, qoff, Kb, Vt, CAT, bh >> 2, bh & 3, 2 * rp, tid, lane, wave); }
            MIX_CHUNKS(NCHK)
#undef MIX_CHUNKS
            }
        }
        xcd_barrier(bar, wave0);
        if (PROBE & 64) xcd_barrier(bar, wave0);
    }
    for (int rep = 0; rep < ((PROBE & 128) ? 2 : 1); ++rep) { TID_VIEW(); const float* sq = ssq + (size_t)6 * M; const f32x4* gr = (const f32x4*)a.in[17] + lane * 2;
      const f32x4 g0 = gr[0], g1 = gr[1], g2 = gr[128], g3 = gr[129];
      for (int m0 = gw; m0 < M; m0 += 4 * NGW) {
        v4u p[4][2];
#pragma unroll
        for (int q = 0; q < 4; ++q) { const int m = m0 + q * NGW; const v4u* xr = (const v4u*)(XB + (size_t)(m < M ? m : m0) * D) + lane; p[q][0] = xr[0]; p[q][1] = xr[64]; }
#pragma unroll
        for (int q = 0; q < 4; ++q) { const int m = m0 + q * NGW; if (m < M) { const float r = pg8::rstd_of(sq, m); f32x4* orow = (f32x4*)(a.out + (size_t)m * D) + lane * 2;
            float f[8]; UNPACK8(p[q][0], f);
            orow[0] = (f32x4){f[0] * r * g0.x, f[1] * r * g0.y, f[2] * r * g0.z, f[3] * r * g0.w}; orow[1] = (f32x4){f[4] * r * g1.x, f[5] * r * g1.y, f[6] * r * g1.z, f[7] * r * g1.w};
            UNPACK8(p[q][1], f);
            orow[128] = (f32x4){f[0] * r * g2.x, f[1] * r * g2.y, f[2] * r * g2.z, f[3] * r * g2.w}; orow[129] = (f32x4){f[4] * r * g3.x, f[5] * r * g3.y, f[6] * r * g3.z, f[7] * r * g3.w}; } }
      } }
}

extern "C" void kernel_launch(void* const* d_in, const int* in_sizes, int n_in, void* d_out, int out_size, void* d_ws, size_t ws_size, hipStream_t stream) {
    static int grid = 0;
    if (grid == 0) {
        if (n_in != 18 || in_sizes[0] != M * D || out_size != M * D || ws_size < WS_END) { fprintf(stderr, "kernel_launch: unexpected shapes (n_in %d, in0 %d, out %d, ws %zu)\n", n_in, n_in > 0 ? in_sizes[0] : -1, out_size, ws_size); grid = -1; return; }
        int dev = 0, cus = 0, per_cu = 0;
        if (hipGetDevice(&dev) != hipSuccess || hipDeviceGetAttribute(&cus, hipDeviceAttributeMultiprocessorCount, dev) != hipSuccess) { grid = -1; return; }
        if (hipFuncSetAttribute((const void*)fwd_megakernel, hipFuncAttributeMaxDynamicSharedMemorySize, LDS_BYTES) != hipSuccess) { fprintf(stderr, "kernel_launch: hipFuncSetAttribute failed\n"); grid = -1; return; }
        if (hipOccupancyMaxActiveBlocksPerMultiprocessor(&per_cu, (const void*)fwd_megakernel, NWAVES * 64, LDS_BYTES) != hipSuccess || per_cu < 1) { fprintf(stderr, "kernel_launch: occupancy query says %d\n", per_cu); per_cu = 1; }
        (void)hipGetLastError();
        grid = cus * 1;
    }
    if (grid < 0) return;
    Args a{};
    for (int i = 0; i < 18; ++i) a.in[i] = (const float*)d_in[i];
    a.out = (float*)d_out; a.ws = (unsigned char*)d_ws;
    if (hipMemsetAsync((char*)d_ws + WS_BAR, 0, BAR_ZERO_BYTES, stream) != hipSuccess) { fprintf(stderr, "kernel_launch: memset failed\n"); return; }
    void* args[] = {&a};
    hipError_t e = hipLaunchCooperativeKernel((const void*)fwd_megakernel, dim3(grid), dim3(NWAVES * 64), args, LDS_BYTES, stream);
    if (e != hipSuccess) fprintf(stderr, "kernel_launch: cooperative launch failed: %s (grid %d)\n", hipGetErrorString(e), grid);
}
```

```cpp
#include <hip/hip_runtime.h>
#include <hip/hip_cooperative_groups.h>
#include <cstdio>
#include <cstdint>
namespace cg = cooperative_groups;
#ifndef PROBE
#define PROBE 0
#endif
#ifndef K_ALIGN
#define K_ALIGN true
#endif
#ifndef RELAX_EPI
#define RELAX_EPI false
#endif
#ifndef USE_PRE
#define USE_PRE true
#endif
#ifndef K_SP2_RESID
#define K_SP2_RESID K_SP2
#endif
#ifndef PG8_WGM
#define PG8_WGM 8
#endif
#ifndef K_SP2
#define K_SP2 true
#endif
namespace pg8 {
#define PG8_LAS __attribute__((address_space(3)))
typedef unsigned short bf16_t;
typedef short bf16x8 __attribute__((ext_vector_type(8)));
typedef float f32x4 __attribute__((ext_vector_type(4)));
typedef unsigned u32x4 __attribute__((ext_vector_type(4)));
typedef int v4i_t __attribute__((ext_vector_type(4)));
typedef unsigned u32x2 __attribute__((ext_vector_type(2)));
constexpr int BM = 256, BK = 64, HALF = 128, HTB = HALF * BK * 2  , STAGE_BYTES = 8 * HTB, NXCD = 8, WGM = PG8_WGM;

__host__ __device__ __forceinline__ int lds_byte(int r, int c) { const int st = (r >> 4) * 2 + (c >> 5), rr = r & 15, cc = c & 31, ob = rr * 64 + cc * 2; return st * 1024 + (ob ^ (((ob >> 9) & 1) << 5)); }
__host__ __device__ __forceinline__ void stage_rc(int b, int& R, int& C) { const int st = b / 1024, sb = b % 1024, swz = sb ^ (((sb >> 9) & 1) << 5); R = (st >> 1) * 16 + swz / 64; C = (st & 1) * 32 + (swz % 64) / 2; }
__host__ __device__ __forceinline__ int perm32(int rho) { const int n = rho >> 4, i = rho & 15; return 8 * (i >> 2) + 4 * n + (i & 3); }

struct Unit { int pm, pn; };
struct Gemm { const bf16_t* A; const bf16_t* Bt; int M, N, K; };

struct StaticOrder {
    int nM, nN, nwg, G, c;
    __host__ __device__ void init(int M, int N, int G_, int c_) { nM = M / BM; nN = N / BM; nwg = nM * nN; G = G_; c = c_; }
    __host__ __device__ bool next(int i, Unit& u) const {
        const long L = (long)i * G + c; if (L >= nwg) return false;
        int wgid = (int)L; { const int q = nwg / NXCD, r = nwg % NXCD, xcd = wgid % NXCD, off = wgid / NXCD; wgid = (xcd < r ? xcd * (q + 1) : r * (q + 1) + (xcd - r) * q) + off; }
        const int nig = WGM * nN, gid = wgid / nig, fm = gid * WGM, gsz = (nM - fm) < WGM ? (nM - fm) : WGM;
        u.pm = fm + ((wgid % nig) % gsz); u.pn = (wgid % nig) / gsz; return true;
    }
    __device__ __forceinline__ void a_ready(const Unit&) const {}
    __device__ __forceinline__ void done(const Unit&) const {}
};

__device__ __forceinline__ unsigned cvt_pk_bf16(float lo, float hi) { unsigned r; asm volatile("v_cvt_pk_bf16_f32 %0, %1, %2" : "=v"(r) : "v"(lo), "v"(hi)); return r; }
typedef float f32x2 __attribute__((ext_vector_type(2)));
constexpr float RMS_EPS = 1e-6f;
constexpr float SSQ_FX = 1024.0f;
__device__ __forceinline__ float rstd_from_bits(unsigned bits) { return __builtin_amdgcn_rsqf((float)bits * (1.0f / (1024.0f * SSQ_FX)) + RMS_EPS); }
__device__ __forceinline__ float rstd_of(const float* ssq, int row) { return rstd_from_bits(((const unsigned*)ssq)[row]); }

template <bool OUT8, bool IN8 = false> struct EpiSwigluT {
    static constexpr bool FP8 = IN8, PERM = true, AFTER_DRAIN = false, PRE = USE_PRE; static constexpr int NST = 8;
    bf16_t* O; const float* ssq; int ldo;
    __device__ __forceinline__ void operator()(const f32x4 (&acc)[2][2][4][2], const Unit& u, int wr, int wc, int fr, int fq, const PG8_LAS float* rs) const {
        const int row0 = u.pm * BM + wr * 64 + fr, col0 = u.pn * HALF + wc * 32 + 8 * fq;
        float rr[2][4];
#pragma unroll
        for (int ai = 0; ai < 2; ++ai)
#pragma unroll
            for (int m = 0; m < 4; ++m) rr[ai][m] = USE_PRE ? rs[wr * 64 + fr + ai * HALF + m * 16] : rstd_of(ssq, row0 + ai * HALF + m * 16);
#pragma unroll
        for (int ai = 0; ai < 2; ++ai)
#pragma unroll
            for (int m = 0; m < 4; ++m) {
                const int row = row0 + ai * HALF + m * 16;
                const float r = IN8 ? rr[ai][m] * (1.0f / 32.0f) : rr[ai][m];
                const float k1 = -1.4426950408889634f * r, r2 = r * r;
                unsigned w[4]; f32x2 hh[2][2];
#pragma unroll
                for (int n = 0; n < 2; ++n)
#pragma unroll
                    for (int j = 0; j < 2; ++j) {
                        const f32x2 gg = (f32x2){acc[ai][0][m][n][2 * j], acc[ai][0][m][n][2 * j + 1]}, uu = (f32x2){acc[ai][1][m][n][2 * j], acc[ai][1][m][n][2 * j + 1]};
                        const f32x2 x = gg * k1; f32x2 ex; ex.x = __builtin_amdgcn_exp2f(x.x); ex.y = __builtin_amdgcn_exp2f(x.y);
                        const f32x2 d = ex + 1.0f; f32x2 q; q.x = __builtin_amdgcn_rcpf(d.x); q.y = __builtin_amdgcn_rcpf(d.y);
                        const f32x2 h = ((gg * uu) * r2) * q;
                        if constexpr (!OUT8) w[2 * n + j] = cvt_pk_bf16(h.x, h.y);
                        else hh[n][j] = h;
                    }
                if constexpr (OUT8) {
#pragma unroll
                    for (int n = 0; n < 2; ++n) { int p = __builtin_amdgcn_cvt_pk_fp8_f32(hh[n][0].x, hh[n][0].y, 0, false); p = __builtin_amdgcn_cvt_pk_fp8_f32(hh[n][1].x, hh[n][1].y, p, true); w[n] = (unsigned)p; } }
                if constexpr (!OUT8) __builtin_nontemporal_store((u32x4){w[0], w[1], w[2], w[3]}, (u32x4*)(O + (size_t)row * ldo + col0));
                else __builtin_nontemporal_store((u32x2){w[0], w[1]}, (u32x2*)((unsigned char*)O + (size_t)row * ldo + col0));
            }
    }
};
template <bool IN8, long X8D = 0> struct EpiResidT {
    static constexpr bool FP8 = IN8, PERM = true, AFTER_DRAIN = false, PRE = false; static constexpr int NST = 24;
    const float* xin; bf16_t* xb; float* ssq; float s;
    __device__ __forceinline__ void finish_row(const f32x4 (&v)[2][2], int row, int col0, int fq) const {
        float sq = 0.f;
#pragma unroll
        for (int bj = 0; bj < 2; ++bj) {
            const f32x4 v0 = v[bj][0], v1 = v[bj][1];
            u32x4 w; w.x = cvt_pk_bf16(v0[0], v0[1]); w.y = cvt_pk_bf16(v0[2], v0[3]); w.z = cvt_pk_bf16(v1[0], v1[1]); w.w = cvt_pk_bf16(v1[2], v1[3]);
            *(u32x4*)(xb + (size_t)row * 1024 + col0 + bj * HALF) = w;
            if constexpr (X8D != 0) { int p0 = __builtin_amdgcn_cvt_pk_fp8_f32(v0[0], v0[1], 0, false); p0 = __builtin_amdgcn_cvt_pk_fp8_f32(v0[2], v0[3], p0, true);
                int p1 = __builtin_amdgcn_cvt_pk_fp8_f32(v1[0], v1[1], 0, false); p1 = __builtin_amdgcn_cvt_pk_fp8_f32(v1[2], v1[3], p1, true);
                *(u32x2*)((unsigned char*)xb + X8D + (size_t)row * 1024 + col0 + bj * HALF) = (u32x2){(unsigned)p0, (unsigned)p1}; }
            sq += (v0[0] * v0[0] + v0[1] * v0[1]) + (v0[2] * v0[2] + v0[3] * v0[3]) + (v1[0] * v1[0] + v1[1] * v1[1]) + (v1[2] * v1[2] + v1[3] * v1[3]);
        }
        sq += __shfl_xor(sq, 16); sq += __shfl_xor(sq, 32);
        if (fq == 0) (void)__hip_atomic_fetch_add((unsigned*)ssq + row, (unsigned)(sq * SSQ_FX + 0.5f), __ATOMIC_RELAXED, __HIP_MEMORY_SCOPE_AGENT);
    }
    __device__ __forceinline__ void operator()(const f32x4 (&acc)[2][2][4][2], const Unit& u, int wr, int wc, int fr, int fq, const PG8_LAS float*) const {
        const int row0 = u.pm * BM + wr * 64 + fr, col0 = u.pn * BM + wc * 32 + 8 * fq;
        if (xin) {
#pragma unroll
            for (int ai = 0; ai < 2; ++ai) {
                f32x4 x[4][2][2];
#pragma unroll
                for (int m = 0; m < 4; ++m)
#pragma unroll
                    for (int bj = 0; bj < 2; ++bj) { const float* p = xin + (size_t)(row0 + ai * HALF + m * 16) * 1024 + col0 + bj * HALF; x[m][bj][0] = *(const f32x4*)p; x[m][bj][1] = *(const f32x4*)(p + 4); }
#pragma unroll
                for (int m = 0; m < 4; ++m) { f32x4 v[2][2];
#pragma unroll
                    for (int bj = 0; bj < 2; ++bj) { v[bj][0] = x[m][bj][0] + acc[ai][bj][m][0] * s; v[bj][1] = x[m][bj][1] + acc[ai][bj][m][1] * s; }
                    finish_row(v, row0 + ai * HALF + m * 16, col0, fq); }
            }
        } else {
            u32x4 p[2][4][2];
#pragma unroll
            for (int ai = 0; ai < 2; ++ai)
#pragma unroll
                for (int m = 0; m < 4; ++m)
#pragma unroll
                    for (int bj = 0; bj < 2; ++bj) p[ai][m][bj] = *(const u32x4*)(xb + (size_t)(row0 + ai * HALF + m * 16) * 1024 + col0 + bj * HALF);
#pragma unroll
            for (int ai = 0; ai < 2; ++ai)
#pragma unroll
                for (int m = 0; m < 4; ++m) { f32x4 v[2][2];
#pragma unroll
                    for (int bj = 0; bj < 2; ++bj) { const u32x4 q = p[ai][m][bj];
                        const f32x4 x0 = (f32x4){__uint_as_float(q.x << 16), __uint_as_float(q.x & 0xffff0000u), __uint_as_float(q.y << 16), __uint_as_float(q.y & 0xffff0000u)};
                        const f32x4 x1 = (f32x4){__uint_as_float(q.z << 16), __uint_as_float(q.z & 0xffff0000u), __uint_as_float(q.w << 16), __uint_as_float(q.w & 0xffff0000u)};
                        v[bj][0] = x0 + acc[ai][bj][m][0] * s; v[bj][1] = x1 + acc[ai][bj][m][1] * s; }
                    finish_row(v, row0 + ai * HALF + m * 16, col0, fq); }
        }
    }
};
struct EpiBf16S {
    static constexpr bool FP8 = false, PERM = true, AFTER_DRAIN = false, PRE = USE_PRE; static constexpr int NST = 16;
    bf16_t* O; int ldc; const float* ssq;
    __device__ __forceinline__ void operator()(const f32x4 (&acc)[2][2][4][2], const Unit& u, int wr, int wc, int fr, int fq, const PG8_LAS float* rs) const {
        const int row0 = u.pm * BM + wr * 64 + fr, col0 = u.pn * BM + wc * 32 + 8 * fq;
        float rr[2][4];
#pragma unroll
        for (int ai = 0; ai < 2; ++ai)
#pragma unroll
            for (int m = 0; m < 4; ++m) rr[ai][m] = USE_PRE ? rs[wr * 64 + fr + ai * HALF + m * 16] : (ssq ? rstd_of(ssq, row0 + ai * HALF + m * 16) : 1.0f);
#pragma unroll
        for (int ai = 0; ai < 2; ++ai)
#pragma unroll
            for (int m = 0; m < 4; ++m) {
                const int row = row0 + ai * HALF + m * 16;
                const float r = rr[ai][m];
#pragma unroll
                for (int bj = 0; bj < 2; ++bj) {
                    const f32x4 v0 = acc[ai][bj][m][0] * r, v1 = acc[ai][bj][m][1] * r;
                    u32x4 w; w.x = cvt_pk_bf16(v0[0], v0[1]); w.y = cvt_pk_bf16(v0[2], v0[3]); w.z = cvt_pk_bf16(v1[0], v1[1]); w.w = cvt_pk_bf16(v1[2], v1[3]);
                    *(u32x4*)(O + (size_t)row * ldc + col0 + bj * HALF) = w;
                }
            }
    }
};
struct EpiWin0 {
    static constexpr bool FP8 = false, PERM = true, AFTER_DRAIN = false, PRE = USE_PRE; static constexpr int NST = 8;
    bf16_t* O; const float* ssq;
    __device__ __forceinline__ void operator()(const f32x4 (&acc)[2][2][4][2], const Unit& u, int wr, int wc, int fr, int fq, const PG8_LAS float* rs) const {
        const int row0 = u.pm * BM + wr * 64 + fr;
        float rr[2][4];
#pragma unroll
        for (int ai = 0; ai < 2; ++ai)
#pragma unroll
            for (int m = 0; m < 4; ++m) rr[ai][m] = USE_PRE ? rs[wr * 64 + fr + ai * HALF + m * 16] : rstd_of(ssq, row0 + ai * HALF + m * 16);
        if (u.pn >= 3 && u.pn < 9) {
            const int col0 = 768 + (u.pn - 3) * HALF + wc * 32 + 8 * fq;
#pragma unroll
            for (int ai = 0; ai < 2; ++ai)
#pragma unroll
                for (int m = 0; m < 4; ++m) { const float r2 = rr[ai][m] * rr[ai][m];
                    const f32x4 v0 = acc[ai][0][m][0] * acc[ai][1][m][0] * r2, v1 = acc[ai][0][m][1] * acc[ai][1][m][1] * r2;
                    u32x4 w; w.x = cvt_pk_bf16(v0[0], v0[1]); w.y = cvt_pk_bf16(v0[2], v0[3]); w.z = cvt_pk_bf16(v1[0], v1[1]); w.w = cvt_pk_bf16(v1[2], v1[3]);
                    *(u32x4*)(O + (size_t)(row0 + ai * HALF + m * 16) * 1792 + col0) = w; }
        } else {
            const int col0 = (u.pn < 3 ? u.pn * BM : 1536) + wc * 32 + 8 * fq;
#pragma unroll
            for (int ai = 0; ai < 2; ++ai)
#pragma unroll
                for (int m = 0; m < 4; ++m) { const float r = rr[ai][m];
#pragma unroll
                    for (int bj = 0; bj < 2; ++bj) { const f32x4 v0 = acc[ai][bj][m][0] * r, v1 = acc[ai][bj][m][1] * r;
                        u32x4 w; w.x = cvt_pk_bf16(v0[0], v0[1]); w.y = cvt_pk_bf16(v0[2], v0[3]); w.z = cvt_pk_bf16(v1[0], v1[1]); w.w = cvt_pk_bf16(v1[2], v1[3]);
                        *(u32x4*)(O + (size_t)(row0 + ai * HALF + m * 16) * 1792 + col0 + bj * HALF) = w; } }
        }
    }
};
struct EpiNull {
    static constexpr bool FP8 = false, PERM = true, AFTER_DRAIN = false, PRE = false; static constexpr int NST = 0;
    float* sink;
    __device__ __forceinline__ void operator()(const f32x4 (&acc)[2][2][4][2], const Unit& u, int wr, int wc, int fr, int fq, const PG8_LAS float*) const {
        float t = 0.f;
#pragma unroll
        for (int ai = 0; ai < 2; ++ai)
#pragma unroll
            for (int bj = 0; bj < 2; ++bj)
#pragma unroll
                for (int m = 0; m < 4; ++m)
#pragma unroll
                    for (int n = 0; n < 2; ++n) t += (acc[ai][bj][m][n][0] + acc[ai][bj][m][n][1]) + (acc[ai][bj][m][n][2] + acc[ai][bj][m][n][3]);
        if (t == 123456.78125f) sink[u.pm * 256 + fr] = t;
    }
};
typedef EpiSwigluT<false> EpiSwiglu; typedef EpiSwigluT<true> EpiSwiglu8; typedef EpiSwigluT<true, true> EpiSwiglu88; typedef EpiSwigluT<false, true> EpiSwiglu08; typedef EpiResidT<false> EpiResid; typedef EpiResidT<true> EpiResid8;
template <class Epi, class Sched, bool ALIGN_EPI = false, bool SP2 = false>
__device__ __forceinline__ void gemm_phase(PG8_LAS unsigned char* lds, PG8_LAS float* rs, const Gemm g, const Sched& S, const Epi& E) {
    int tid = threadIdx.x; asm volatile("" : "+v"(tid));
    const int wid = __builtin_amdgcn_readfirstlane(tid >> 6), lane = tid & 63, wr = wid >> 2, wc = wid & 3, fr = lane & 15, fq = lane >> 4;
    const int K = g.K, nt = K / BK;
    unsigned voffA, voffB;
    { int R, C; stage_rc(tid * 16, R, C); const int Rb = Epi::PERM ? ((R & ~31) + perm32(R & 31)) : R;
        voffA = (unsigned)(R * K + C) * 2u; voffB = (unsigned)(Rb * K + C) * 2u; }
    const size_t qstep = (size_t)64 * K * 2;
    const size_t kstep = (size_t)(BK * 2);
    const size_t hstep = (size_t)HALF * K * 2;
    const size_t tstep = 2 * hstep;
    const unsigned ldsw = (unsigned)wid * 1024u;
    const int aoff = lds_byte(wr * 64 + fr, fq * 8), boff = lds_byte(wc * 32 + fr, fq * 8);
#define PG8_SA(b, h) (((b) * 2 + (h)) * HTB)
#define PG8_SB(b, h) ((4 + (b) * 2 + (h)) * HTB)
#define PG8_STAGE(bufoff, gbase, voff) do { _Pragma("unroll") for (int _i = 0; _i < 2; ++_i) \
        __builtin_amdgcn_global_load_lds((const unsigned*)((const char*)(gbase) + _i * qstep + (voff)), (PG8_LAS unsigned*)(lds + (bufoff) + ldsw + _i * 8192), 16, 0, 0); } while (0)
#define PG8_LDA(dst, b, h) do { _Pragma("unroll") for (int m = 0; m < 4; ++m) _Pragma("unroll") for (int k = 0; k < 2; ++k) dst[m][k] = *(const PG8_LAS bf16x8*)(lds + PG8_SA(b, h) + aoff + m * 2048 + k * 1024); } while (0)
#define PG8_LDB(dst, b, h) do { _Pragma("unroll") for (int n = 0; n < 2; ++n) _Pragma("unroll") for (int k = 0; k < 2; ++k) dst[n][k] = *(const PG8_LAS bf16x8*)(lds + PG8_SB(b, h) + boff + n * 2048 + k * 1024); } while (0)
#define PG8_CAT8(x, y) __builtin_shufflevector(__builtin_bit_cast(v4i_t, (x)), __builtin_bit_cast(v4i_t, (y)), 0, 1, 2, 3, 4, 5, 6, 7)
#define PG8_MMA(ai, bj, At, Bt) do { __builtin_amdgcn_s_setprio(1); \
        if constexpr (Epi::FP8) {   \
            _Pragma("unroll") for (int m = 0; m < 4; ++m) _Pragma("unroll") for (int n = 0; n < 2; ++n) \
                asm volatile("v_mfma_scale_f32_16x16x128_f8f6f4 %0, %1, %2, %0, %3, %3 op_sel_hi:[0,0,0]" : "+v"(acc[ai][bj][m][n]) : "v"(PG8_CAT8(Bt[n][0], Bt[n][1])), "v"(PG8_CAT8(At[m][0], At[m][1])), "v"(sc8));   \
        } else { \
            _Pragma("unroll") for (int m = 0; m < 4; ++m) _Pragma("unroll") for (int n = 0; n < 2; ++n) _Pragma("unroll") for (int k = 0; k < 2; ++k) \
                acc[ai][bj][m][n] = __builtin_amdgcn_mfma_f32_16x16x32_bf16(Bt[n][k], At[m][k], acc[ai][bj][m][n], 0, 0, 0); } \
        __builtin_amdgcn_s_setprio(0); } while (0)
#define PG8_WAIT_V(n) asm volatile("s_waitcnt vmcnt(" #n ")" ::: "memory")
#define PG8_WAIT_VN(N) asm volatile("s_waitcnt vmcnt(%0)" :: "n"(N) : "memory")
#define PG8_WAIT_L(n) asm volatile("s_waitcnt lgkmcnt(" #n ")" ::: "memory")
#define PG8_BAR __builtin_amdgcn_s_barrier()
#define PG8_SCHED __builtin_amdgcn_sched_barrier(0)
    Unit cur, nxt; int ui = 0;
    if (!S.next(0, cur)) return;
    f32x4 acc[2][2][4][2];
#pragma unroll
    for (int a = 0; a < 2; ++a)
#pragma unroll
        for (int b = 0; b < 2; ++b)
#pragma unroll
            for (int m = 0; m < 4; ++m)
#pragma unroll
                for (int n = 0; n < 2; ++n) acc[a][b][m][n] = (f32x4){0.f, 0.f, 0.f, 0.f};
    bf16x8 At[4][2], B0[2][2], B1[2][2];
    const unsigned sc8 = 0x7f7f7f7fu; (void)sc8;
    const char* cA = (const char*)g.A + (size_t)cur.pm * tstep; const char* cB = (const char*)g.Bt + (size_t)cur.pn * tstep;
    S.a_ready(cur);
    float pre = 1.0f;
#define PG8_PRELOAD(u) do { if constexpr (Epi::PRE) { if (E.ssq) { const float* _p = E.ssq + (u).pm * BM + (tid & (BM - 1)); asm volatile("global_load_dword %0, %1, off" : "=v"(pre) : "v"(_p) : "memory"); } } } while (0)
    PG8_PRELOAD(cur);
    if constexpr (SP2) {
        PG8_STAGE(PG8_SB(0, 0), cB, voffB); PG8_STAGE(PG8_SB(0, 1), cB + hstep, voffB); PG8_STAGE(PG8_SA(0, 0), cA, voffA); PG8_STAGE(PG8_SA(0, 1), cA + hstep, voffA);
        if (wr == 1) PG8_BAR;
        PG8_WAIT_V(2); PG8_BAR;
        PG8_STAGE(PG8_SB(1, 0), cB + kstep, voffB); PG8_STAGE(PG8_SA(1, 0), cA + kstep, voffA); PG8_STAGE(PG8_SB(1, 1), cB + hstep + kstep, voffB);
        PG8_WAIT_V(6); PG8_BAR;
    } else {
        PG8_STAGE(PG8_SB(0, 0), cB, voffB); PG8_STAGE(PG8_SA(0, 0), cA, voffA); PG8_STAGE(PG8_SB(0, 1), cB + hstep, voffB); PG8_STAGE(PG8_SA(0, 1), cA + hstep, voffA);
        if (wr == 1) PG8_BAR;
        PG8_WAIT_V(4); PG8_BAR;
        PG8_STAGE(PG8_SB(1, 0), cB + kstep, voffB); PG8_STAGE(PG8_SA(1, 0), cA + kstep, voffA); PG8_STAGE(PG8_SB(1, 1), cB + hstep + kstep, voffB);
        PG8_WAIT_V(6); PG8_BAR;
    }
    for (;;) {
        const bool has_next = S.next(ui + 1, nxt);
        const char* nA = has_next ? (const char*)g.A + (size_t)nxt.pm * tstep : cA; const char* nB = has_next ? (const char*)g.Bt + (size_t)nxt.pn * tstep : cB;
        for (int t = 0; t < nt; t += 2) {
            const bool last = (t == nt - 2);
            const bool relax = RELAX_EPI && (t == 0) && (ui > 0);
            const char* a1 = cA + (size_t)(t + 1) * kstep;
            const char* a2 = last ? nA : cA + (size_t)(t + 2) * kstep; const char* b2 = last ? nB : cB + (size_t)(t + 2) * kstep;
            const char* a3 = a2 + kstep; const char* b3 = b2 + kstep;
            if (last && has_next) S.a_ready(nxt);
            if constexpr (SP2) {
            PG8_LDB(B0, 0, 0); PG8_LDB(B1, 0, 1); PG8_SCHED; PG8_LDA(At, 0, 0); PG8_STAGE(PG8_SA(1, 1), a1 + hstep, voffA);
            if (relax) PG8_WAIT_VN(8 + Epi::NST); else PG8_WAIT_V(8); PG8_WAIT_L(0); PG8_BAR; PG8_MMA(0, 0, At, B0); PG8_MMA(0, 1, At, B1); PG8_BAR; PG8_SCHED;
            PG8_LDA(At, 0, 1); PG8_STAGE(PG8_SB(0, 0), b2, voffB); PG8_STAGE(PG8_SB(0, 1), b2 + hstep, voffB); PG8_STAGE(PG8_SA(0, 0), a2, voffA);
            if (relax) PG8_WAIT_VN(8 + Epi::NST); else PG8_WAIT_V(8); PG8_WAIT_L(0); PG8_BAR; PG8_MMA(1, 0, At, B0); PG8_MMA(1, 1, At, B1); PG8_BAR; PG8_SCHED;
            PG8_LDB(B0, 1, 0); PG8_LDB(B1, 1, 1); PG8_SCHED; PG8_LDA(At, 1, 0); PG8_STAGE(PG8_SA(0, 1), a2 + hstep, voffA);
            PG8_WAIT_V(8); PG8_WAIT_L(0); PG8_BAR; PG8_MMA(0, 0, At, B0); PG8_MMA(0, 1, At, B1); PG8_BAR; PG8_SCHED;
            PG8_LDA(At, 1, 1); PG8_STAGE(PG8_SB(1, 0), b3, voffB); PG8_STAGE(PG8_SB(1, 1), b3 + hstep, voffB); PG8_STAGE(PG8_SA(1, 0), a3, voffA);
            PG8_WAIT_V(8); PG8_WAIT_L(0); PG8_BAR; PG8_MMA(1, 0, At, B0); PG8_MMA(1, 1, At, B1); PG8_BAR; PG8_SCHED;
            } else {
            PG8_LDB(B0, 0, 0); PG8_SCHED; PG8_LDA(At, 0, 0); PG8_STAGE(PG8_SA(1, 1), a1 + hstep, voffA);
            PG8_WAIT_L(8); PG8_BAR; PG8_WAIT_L(0); PG8_MMA(0, 0, At, B0); PG8_BAR; PG8_SCHED;
            PG8_LDB(B1, 0, 1); PG8_STAGE(PG8_SB(0, 0), b2, voffB);
            PG8_BAR; PG8_WAIT_L(0); PG8_MMA(0, 1, At, B1); PG8_BAR;
            PG8_LDA(At, 0, 1); PG8_STAGE(PG8_SA(0, 0), a2, voffA);
            PG8_BAR; PG8_WAIT_L(0); PG8_MMA(1, 0, At, B0); PG8_BAR; PG8_SCHED;
            PG8_STAGE(PG8_SB(0, 1), b2 + hstep, voffB);
            PG8_WAIT_V(6); PG8_BAR; PG8_MMA(1, 1, At, B1); PG8_BAR;
            PG8_LDB(B0, 1, 0); PG8_SCHED; PG8_LDA(At, 1, 0); PG8_STAGE(PG8_SA(0, 1), a2 + hstep, voffA);
            PG8_WAIT_L(8); PG8_BAR; PG8_WAIT_L(0); PG8_MMA(0, 0, At, B0); PG8_BAR; PG8_SCHED;
            PG8_LDB(B1, 1, 1); PG8_STAGE(PG8_SB(1, 0), b3, voffB);
            PG8_BAR; PG8_WAIT_L(0); PG8_MMA(0, 1, At, B1); PG8_BAR;
            PG8_LDA(At, 1, 1); PG8_STAGE(PG8_SA(1, 0), a3, voffA);
            PG8_BAR; PG8_WAIT_L(0); PG8_MMA(1, 0, At, B0); PG8_BAR; PG8_SCHED;
            PG8_STAGE(PG8_SB(1, 1), b3 + hstep, voffB);
            PG8_WAIT_V(6); PG8_BAR; PG8_MMA(1, 1, At, B1); PG8_BAR;
            }
        }
        if constexpr (ALIGN_EPI && Epi::PRE) {
            if (wr == 0) { rs[tid] = E.ssq ? rstd_from_bits(__float_as_uint(pre)) : 1.0f; PG8_WAIT_L(0); PG8_BAR; }
            asm volatile("" ::: "memory");
        } else {
        if constexpr (ALIGN_EPI) { if (wr == 0) PG8_BAR; }
        if constexpr (Epi::PRE) {
            if (tid < BM) rs[tid] = E.ssq ? rstd_from_bits(__float_as_uint(pre)) : 1.0f;
            PG8_WAIT_L(0); PG8_BAR; asm volatile("" ::: "memory");
        }
        }
        if constexpr (!Epi::AFTER_DRAIN) { E(acc, cur, wr, wc, fr, fq, rs); S.done(cur); }
        if (!has_next) break;
#pragma unroll
        for (int a = 0; a < 2; ++a)
#pragma unroll
            for (int b = 0; b < 2; ++b)
#pragma unroll
                for (int m = 0; m < 4; ++m)
#pragma unroll
                    for (int n = 0; n < 2; ++n) acc[a][b][m][n] = (f32x4){0.f, 0.f, 0.f, 0.f};
        cur = nxt; cA = nA; cB = nB; ++ui;
        PG8_PRELOAD(cur);
        if constexpr (ALIGN_EPI) { if (wr == 1) PG8_BAR; }
    }
    PG8_WAIT_V(0);
    if constexpr (!ALIGN_EPI) { if (wr == 0) PG8_BAR; }
    PG8_BAR;
    if constexpr (Epi::AFTER_DRAIN) { E.fused(acc, cur, wr, wc, fr, fq, lds, wid, lane); S.done(cur); }
#undef PG8_PRELOAD
#undef PG8_SA
#undef PG8_SB
#undef PG8_STAGE
#undef PG8_LDA
#undef PG8_LDB
#undef PG8_MMA
#undef PG8_CAT8
#undef PG8_WAIT_V
#undef PG8_WAIT_L
#undef PG8_WAIT_VN
#undef PG8_BAR
#undef PG8_SCHED
}
}
constexpr int NWAVES = 8;
#ifndef F8MASK
#define F8MASK 12
#endif
constexpr int F8_DOWN = F8MASK;
#ifndef F8GU
#define F8GU 8
#endif
constexpr int F8_GU = F8GU;
constexpr float GU8_SCALE = 32.0f;
__device__ __forceinline__ bool f8_gu(int idx) { return ((F8_GU >> idx) & 1) != 0; }
constexpr float W8_SCALE = 64.0f;
__device__ __forceinline__ bool f8_down(int idx) { return F8_DOWN == 15 ? true : (F8_DOWN == 0 ? false : ((F8_DOWN >> idx) & 1) != 0); }
constexpr int NB = 4, SEQ = 8192, D = 1024, FF = 2816, M = NB * SEQ, NMEM = 256, MW = 768, XW = 256, MROWS = NB * NMEM;
constexpr int NWIN0 = 3 * MW + XW, NWIN1 = MW + XW, PG = 192, LDZ0 = 2 * MW + XW;
constexpr size_t MiB = 1u << 20;
constexpr size_t WS_SSQ = 0;
constexpr size_t WS_BAR = 896 * 1024, BAR_ZERO_BYTES = 16 * 1024;
constexpr size_t WS_KB = 1 * MiB;
constexpr size_t WS_VT = 2 * MiB;
constexpr size_t WS_MEMN = 3 * MiB;
constexpr size_t WS_WGU = 8 * MiB, SZ_WGU = 11 * MiB;
constexpr size_t WS_WD = 52 * MiB, SZ_WD = (size_t)D * FF * 2;
constexpr size_t WS_WOUT = 74 * MiB, SZ_WOUT = 2 * MiB;
constexpr size_t WS_WKV = 78 * MiB, SZ_WKV = 1 * MiB;
constexpr size_t WS_WIN0 = 80 * MiB, WS_WIN1 = 85 * MiB;
constexpr size_t WS_XB = 88 * MiB;
constexpr size_t WS_CAT = 152 * MiB;
constexpr size_t WS_ACT = 216 * MiB;
constexpr size_t WS_XB8 = 392 * MiB;
constexpr size_t WS_END = 424 * MiB;
static_assert(WS_WD + 4 * SZ_WD <= WS_WOUT && WS_WIN0 + (size_t)NWIN0 * D * 2 <= WS_WIN1 && WS_WIN1 + 2 * MiB <= WS_XB, "ws map");
constexpr int MISC_OFF = 131072, RS_OFF = 131072 + 256, LDS_BYTES = 131072 + 256 + 1024;

#define GAS __attribute__((address_space(1)))
#define LAS __attribute__((address_space(3)))
typedef unsigned short bf16;
typedef unsigned v4u __attribute__((ext_vector_type(4)));
typedef unsigned v2u __attribute__((ext_vector_type(2)));
typedef float f32x4 __attribute__((ext_vector_type(4)));
typedef short bf16x8 __attribute__((ext_vector_type(8)));
#define LDS_WAIT() asm volatile("s_waitcnt lgkmcnt(0)" ::: "memory")
__device__ __forceinline__ unsigned pk2(float lo, float hi) { return pg8::cvt_pk_bf16(lo, hi); }
__device__ __forceinline__ float bflo(unsigned p) { return __uint_as_float(p << 16); }
__device__ __forceinline__ float bfhi(unsigned p) { return __uint_as_float(p & 0xffff0000u); }
__device__ __forceinline__ float wave_sum(float v) {
#pragma unroll
    for (int o = 1; o < 64; o <<= 1) v += __shfl_xor(v, o);
    return v;
}
#define XB_TMO      128
#define XB_XCNT(j)  (256  + 64 * (j))
#define XB_XSUB(j)  (1280 + 64 * (j))
#define XB_XGEN(j)  (2304 + 64 * (j))
#define XB_TOP      3328
#define XB_TOPGEN   3392
#define XCD_BAR_WORDS 3456
#define XB_SPIN_CAP (1u << 18)

__device__ __forceinline__ unsigned xb_ld(unsigned* p)              { return __hip_atomic_load(p, __ATOMIC_RELAXED, __HIP_MEMORY_SCOPE_AGENT); }
__device__ __forceinline__ unsigned xb_add(unsigned* p, unsigned v) { return __hip_atomic_fetch_add(p, v, __ATOMIC_RELAXED, __HIP_MEMORY_SCOPE_AGENT); }
__device__ __forceinline__ unsigned xb_xcc_id() { return (unsigned)__builtin_amdgcn_s_getreg((3 << 11) | 20) & 0xFu; }
#define XB_SPIN(cond, bar) do { unsigned _sp = 0; while (cond) { __builtin_amdgcn_s_sleep(1); \
    if ((++_sp & 255u) == 0u) { if (xb_ld(&(bar)[XB_TMO])) break; if (_sp > XB_SPIN_CAP) { atomicAdd(&(bar)[XB_TMO], 1u); break; } } } } while (0)

struct XcdBarrier {
    unsigned* bar; unsigned x;
    volatile LAS unsigned* st;
};

__device__ __forceinline__ XcdBarrier xcd_barrier_post(unsigned* bar, volatile LAS unsigned* st) {
    XcdBarrier b; b.bar = bar; b.x = xb_xcc_id(); b.st = st;
    if (threadIdx.x == 0) (void)xb_add(&bar[XB_XCNT(b.x)], 1u);
    return b;
}
__device__ __forceinline__ void xcd_barrier_complete(unsigned* bar, unsigned x, unsigned& nloc, unsigned& nx) {
    const unsigned G = gridDim.x * gridDim.y * gridDim.z;
    unsigned sum, cnt, mine, sp = 0u;
    for (;;) {
        sum = 0u; cnt = 0u; mine = 0u;
#pragma unroll
        for (unsigned j = 0; j < 16; ++j) { const unsigned c = xb_ld(&bar[XB_XCNT(j)]); sum += c; cnt += (c > 0u) ? 1u : 0u; mine = (j == x) ? c : mine; }
        if (sum == G) break;
        __builtin_amdgcn_s_sleep(1);
        if ((++sp & 255u) == 0u) { if (xb_ld(&bar[XB_TMO])) break; if (sp > XB_SPIN_CAP) { atomicAdd(&bar[XB_TMO], 1u); break; } }
    }
    nloc = mine > 0u ? mine : 1u; nx = cnt > 0u ? cnt : 1u;
}

__device__ __forceinline__ void xcd_barrier(const XcdBarrier& b) {
    asm volatile("s_waitcnt vmcnt(0)" ::: "memory");
    __syncthreads();
    if (threadIdx.x == 0) {
        unsigned* bar = b.bar;
        __builtin_amdgcn_s_waitcnt(0);
        unsigned nloc = b.st[0], nx = b.st[1];
        if (nloc == 0u) { xcd_barrier_complete(bar, b.x, nloc, nx); b.st[0] = nloc; b.st[1] = nx; }
        const unsigned old = xb_add(&bar[XB_XSUB(b.x)], 1u);
        const unsigned gen = old / nloc;
        if (old + 1u == (gen + 1u) * nloc) {
            __builtin_amdgcn_fence(__ATOMIC_RELEASE, "agent");
            asm volatile("s_waitcnt vmcnt(0)" ::: "memory");
            const unsigned og = xb_add(&bar[XB_TOP], 1u);
            const unsigned tg = og / nx;
            if (og + 1u == (tg + 1u) * nx) xb_add(&bar[XB_TOPGEN], 1u);
            else XB_SPIN(xb_ld(&bar[XB_TOPGEN]) == tg, bar);
            __builtin_amdgcn_fence(__ATOMIC_ACQUIRE, "agent");
            xb_add(&bar[XB_XGEN(b.x)], 1u);
            asm volatile("s_waitcnt vmcnt(0)" ::: "memory");
        } else {
            XB_SPIN(xb_ld(&bar[XB_XGEN(b.x)]) == gen, bar);
            __builtin_amdgcn_fence(__ATOMIC_ACQUIRE, "agent");
            asm volatile("s_waitcnt vmcnt(0)" ::: "memory");
        }
    }
    __syncthreads();
}


struct Args { const float* in[18]; float* out; unsigned char* ws; };

__device__ __forceinline__ void tr_item(const float* W, int N, const float* gain, bf16* WT, int ldk, int koff, int mode, LAS float* scr, int item, int lane, float scale8 = 0.f) {
    const int nblk = N / 32, kb = item / nblk, nb = item % nblk, k0 = 64 * kb, n0 = 32 * nb;
    f32x4 g0 = (f32x4){1.f, 1.f, 1.f, 1.f}, g1 = g0;
    if (gain) { g0 = *(const f32x4*)(gain + k0 + 8 * (lane & 7)); g1 = *(const f32x4*)(gain + k0 + 8 * (lane & 7) + 4); }
    { float v[32];
#pragma unroll
    for (int i = 0; i < 32; ++i) { const int kk = 2 * i + (lane >> 5); v[i] = __builtin_nontemporal_load(W + (size_t)(k0 + kk) * N + n0 + (lane & 31)); }
#pragma unroll
    for (int i = 0; i < 32; ++i) scr[(2 * i + (lane >> 5)) * 33 + (lane & 31)] = v[i]; }
    LDS_WAIT(); asm volatile("" ::: "memory");
    int d0 = n0;
    if (mode == 1) { const int half = n0 >= FF ? 1 : 0, j0 = n0 - half * FF; d0 = 256 * (j0 >> 7) + 128 * half + (j0 & 127); }
    if (mode == 2 && n0 >= MW && n0 < 3 * MW) { const int half = n0 >= 2 * MW ? 1 : 0, j0 = n0 - MW - half * MW; d0 = MW + 256 * (j0 >> 7) + 128 * half + (j0 & 127); }
    const int c = lane & 7;
#pragma unroll
    for (int j = 0; j < 4; ++j) { const int n = (lane >> 3) + 8 * j; const LAS float* s = scr + (8 * c) * 33 + n;
        if (scale8 != 0.f) {
            const f32x4 h0 = g0 * scale8, h1 = g1 * scale8; int lo = 0, hi = 0;
            lo = __builtin_amdgcn_cvt_pk_fp8_f32(s[0 * 33] * h0.x, s[1 * 33] * h0.y, lo, false); lo = __builtin_amdgcn_cvt_pk_fp8_f32(s[2 * 33] * h0.z, s[3 * 33] * h0.w, lo, true);
            hi = __builtin_amdgcn_cvt_pk_fp8_f32(s[4 * 33] * h1.x, s[5 * 33] * h1.y, hi, false); hi = __builtin_amdgcn_cvt_pk_fp8_f32(s[6 * 33] * h1.z, s[7 * 33] * h1.w, hi, true);
            *(v2u*)((unsigned char*)WT + (size_t)(d0 + n) * ldk + koff + k0 + 8 * c) = (v2u){(unsigned)lo, (unsigned)hi};
        } else {
        v4u o; o.x = pk2(s[0 * 33] * g0.x, s[1 * 33] * g0.y); o.y = pk2(s[2 * 33] * g0.z, s[3 * 33] * g0.w); o.z = pk2(s[4 * 33] * g1.x, s[5 * 33] * g1.y); o.w = pk2(s[6 * 33] * g1.z, s[7 * 33] * g1.w);
        *(v4u*)(WT + (size_t)(d0 + n) * ldk + koff + k0 + 8 * c) = o; } }
    LDS_WAIT(); asm volatile("" ::: "memory");
}

__device__ __forceinline__ void prologue(const Args& a, LAS unsigned char* lds, int gw, int NGW, int wave, int lane, int gtid, int NGT) {
    unsigned char* ws = a.ws;
    LAS float* scr = (LAS float*)(lds + wave * 16384);
    constexpr int I_GU = (D / 64) * (2 * FF / 32), I_D = (FF / 64) * (D / 32), I_KV = (D / 64) * (512 / 32), I_O0 = (D / 64) * (D / 32), I_O1 = (XW / 64) * (D / 32),
                  I_W0 = (D / 64) * (NWIN0 / 32), I_W1 = (D / 64) * (NWIN1 / 32), I_FOLD = 4 * (PG / 8) * (D / 64);
    constexpr int NITEMS = 4 * I_GU + 4 * I_D + 2 * I_KV + I_O0 + I_O1 + I_W0 + I_W1 + I_FOLD;
    for (int it = gw; it < NITEMS; it += NGW) {
        int r = it;
        if (r < 4 * I_GU) { const int idx = r / I_GU, l = idx >> 1, f = idx & 1; r -= idx * I_GU;
            tr_item(a.in[f ? 15 : 3] + (size_t)l * D * 2 * FF, 2 * FF, a.in[f ? 14 : 2] + l * D, (bf16*)(ws + WS_WGU + idx * SZ_WGU), D, 0, 1, scr, r, lane, f8_gu(idx) ? GU8_SCALE : 0.f); continue; }
        r -= 4 * I_GU;
        if (r < 4 * I_D) { const int idx = r / I_D, l = idx >> 1, f = idx & 1; r -= idx * I_D;
            tr_item(a.in[f ? 16 : 4] + (size_t)l * FF * D, D, nullptr, (bf16*)(ws + WS_WD + idx * SZ_WD), FF, 0, 0, scr, r, lane, f8_down(idx) ? W8_SCALE : 0.f); continue; }
        r -= 4 * I_D;
        if (r < 2 * I_KV) { const int l = r / I_KV; r -= l * I_KV;
            tr_item(a.in[7] + (size_t)l * D * 512, 512, nullptr, (bf16*)(ws + WS_WKV + l * SZ_WKV), D, 0, 0, scr, r, lane); continue; }
        r -= 2 * I_KV;
        if (r < I_O0) { tr_item(a.in[8], D, nullptr, (bf16*)(ws + WS_WOUT), D, 0, 0, scr, r, lane); continue; }
        r -= I_O0;
        if (r < I_O1) { tr_item(a.in[8] + (size_t)D * D + (size_t)MW * D, D, nullptr, (bf16*)(ws + WS_WOUT + SZ_WOUT), D, MW, 0, scr, r, lane); continue; }
        r -= I_O1;
        if (r < I_W0) { tr_item(a.in[9], NWIN0, a.in[5], (bf16*)(ws + WS_WIN0), D, 0, 2, scr, r, lane); continue; }
        r -= I_W0;
        if (r < I_W1) { tr_item(a.in[11], NWIN1, a.in[5] + D, (bf16*)(ws + WS_WIN1), D, 0, 0, scr, r, lane); continue; }
        r -= I_W1;
        {
            const int nb = r % (D / 64), kb = (r / (D / 64)) % (PG / 8), g = r / ((D / 64) * (PG / 8));
            const int n = nb * 64 + lane;
            const float* Wg = a.in[12] + (size_t)(g * PG + kb * 8) * PG;
            const float* sc = a.in[13] + g * PG;
            const float* Wo = a.in[8] + (size_t)D * D + (size_t)(g * PG) * D + n;
            float acc[8];
#pragma unroll
            for (int e = 0; e < 8; ++e) acc[e] = 0.f;
            for (int j0 = 0; j0 < PG; j0 += 8) { float wv[8];
#pragma unroll
                for (int jj = 0; jj < 8; ++jj) wv[jj] = Wo[(size_t)(j0 + jj) * D];
#pragma unroll
                for (int jj = 0; jj < 8; ++jj) wv[jj] *= sc[j0 + jj];
#pragma unroll
                for (int e = 0; e < 8; ++e)
#pragma unroll
                    for (int jj = 0; jj < 8; ++jj) acc[e] += Wg[e * PG + j0 + jj] * wv[jj]; }
            v4u o; o.x = pk2(acc[0], acc[1]); o.y = pk2(acc[2], acc[3]); o.z = pk2(acc[4], acc[5]); o.w = pk2(acc[6], acc[7]);
            *(v4u*)((bf16*)(ws + WS_WOUT + SZ_WOUT) + (size_t)n * D + g * PG + kb * 8) = o;
        }
    }
    { const float* x = a.in[0]; bf16* xb = (bf16*)(ws + WS_XB); float* ssq0 = (float*)(ws + WS_SSQ);
      for (int m0 = gw; m0 < M; m0 += 4 * NGW) {
        f32x4 v[4][4];
#pragma unroll
        for (int q = 0; q < 4; ++q) { const int m = m0 + q * NGW; const f32x4* xr = (const f32x4*)(x + (size_t)(m < M ? m : m0) * D) + lane;
#pragma unroll
            for (int j = 0; j < 4; ++j) v[q][j] = __builtin_nontemporal_load(xr + 64 * j); }
#pragma unroll
        for (int q = 0; q < 4; ++q) { const int m = m0 + q * NGW; if (m < M) { float s = 0.f;
#pragma unroll
            for (int j = 0; j < 4; ++j) s += (v[q][j].x * v[q][j].x + v[q][j].y * v[q][j].y) + (v[q][j].z * v[q][j].z + v[q][j].w * v[q][j].w);
            s = wave_sum(s);
            if (lane == 0) ((unsigned*)ssq0)[m] = (unsigned)(s * pg8::SSQ_FX + 0.5f);
            v2u* o8 = (v2u*)(xb + (size_t)m * D) + lane;
#pragma unroll
            for (int j = 0; j < 4; ++j) o8[64 * j] = (v2u){pk2(v[q][j].x, v[q][j].y), pk2(v[q][j].z, v[q][j].w)}; } }
      } }
    for (int t = gw; t < 2 * MROWS; t += NGW) { const int l = t / MROWS, m = t % MROWS;
        const f32x4* xr = (const f32x4*)(a.in[1] + (size_t)m * D) + lane; const f32x4* gr = (const f32x4*)(a.in[6] + l * D) + lane; f32x4 v[4]; float s = 0.f;
#pragma unroll
        for (int j = 0; j < 4; ++j) { v[j] = xr[64 * j]; s += (v[j].x * v[j].x + v[j].y * v[j].y) + (v[j].z * v[j].z + v[j].w * v[j].w); }
        const float r = 1.0f / sqrtf(wave_sum(s) * (1.0f / D) + pg8::RMS_EPS);
        v2u* o8 = (v2u*)((bf16*)(ws + WS_MEMN) + (size_t)t * D) + lane;
#pragma unroll
        for (int j = 0; j < 4; ++j) { const f32x4 g = gr[64 * j]; o8[64 * j] = (v2u){pk2(v[j].x * r * g.x, v[j].y * r * g.y), pk2(v[j].z * r * g.z, v[j].w * r * g.w)}; } }
    { float* z = (float*)(ws + WS_SSQ) + M; for (int i = gtid; i < 6 * M; i += NGT) z[i] = 0.f; }
}

constexpr int KROW = 144, VROW = 528, VOFF = 256 * KROW;
__device__ __forceinline__ void attn_unit(LAS unsigned char* lds, const bf16* z, int ldz, int qoff, const bf16* Kb, const bf16* Vt, bf16* cat, int b, int h, int rc0, int tid, int lane, int wave) {
    const int fr = lane & 15, fq = lane >> 4;
    bf16x8 q0[4], q1[4];
#pragma unroll
    for (int i = 0; i < 4; ++i) { const size_t row = (size_t)b * SEQ + (rc0 + (i >> 1)) * 256 + wave * 32 + (i & 1) * 16 + fr;
        const bf16* qp = z + row * ldz + qoff + h * 64 + fq * 8; q0[i] = *(const bf16x8*)qp; q1[i] = *(const bf16x8*)(qp + 32); }
    { v4u kk[4], vv[4];
#pragma unroll
      for (int q = 0; q < 4; ++q) { const int i = tid + q * 512; kk[q] = *(const v4u*)(Kb + (size_t)(b * NMEM + (i >> 3)) * 256 + h * 64 + (i & 7) * 8); vv[q] = *(const v4u*)(Vt + (size_t)(h * 64 + (i >> 5)) * MROWS + b * NMEM + (i & 31) * 8); }
#pragma unroll
      for (int q = 0; q < 4; ++q) { const int i = tid + q * 512; *(LAS v4u*)(lds + (i >> 3) * KROW + (i & 7) * 16) = kk[q]; *(LAS v4u*)(lds + VOFF + (i >> 5) * VROW + (i & 31) * 16) = vv[q]; } }
    __syncthreads();
#pragma unroll
    for (int sb = 0; sb < 4; ++sb) {
        const size_t row = (size_t)b * SEQ + (rc0 + (sb >> 1)) * 256 + wave * 32 + (sb & 1) * 16 + fr;
        f32x4 s[16];
#pragma unroll
        for (int j = 0; j < 16; ++j) {
            const bf16x8 k0 = *(const LAS bf16x8*)(lds + (16 * j + fr) * KROW + fq * 16), k1 = *(const LAS bf16x8*)(lds + (16 * j + fr) * KROW + fq * 16 + 64);
            f32x4 c = (f32x4){0.f, 0.f, 0.f, 0.f};
            c = __builtin_amdgcn_mfma_f32_16x16x32_bf16(k0, q0[sb], c, 0, 0, 0);
            s[j] = __builtin_amdgcn_mfma_f32_16x16x32_bf16(k1, q1[sb], c, 0, 0, 0);
        }
        float mx = s[0][0];
#pragma unroll
        for (int j = 0; j < 16; ++j) mx = fmaxf(fmaxf(fmaxf(mx, s[j][0]), fmaxf(s[j][1], s[j][2])), s[j][3]);
        mx = fmaxf(mx, __shfl_xor(mx, 16)); mx = fmaxf(mx, __shfl_xor(mx, 32));
        const float sc = 0.125f * 1.4426950408889634f; float sum = 0.f;
#pragma unroll
        for (int j = 0; j < 16; ++j)
#pragma unroll
            for (int i = 0; i < 4; ++i) { const float p = __builtin_amdgcn_exp2f((s[j][i] - mx) * sc); s[j][i] = p; sum += p; }
        sum += __shfl_xor(sum, 16); sum += __shfl_xor(sum, 32);
        f32x4 o[4];
#pragma unroll
        for (int c = 0; c < 4; ++c) o[c] = (f32x4){0.f, 0.f, 0.f, 0.f};
#pragma unroll
        for (int t = 0; t < 8; ++t) {
            const v4u pw = (v4u){pk2(s[2 * t][0], s[2 * t][1]), pk2(s[2 * t][2], s[2 * t][3]), pk2(s[2 * t + 1][0], s[2 * t + 1][1]), pk2(s[2 * t + 1][2], s[2 * t + 1][3])};
            const bf16x8 pb = __builtin_bit_cast(bf16x8, pw);
#pragma unroll
            for (int c = 0; c < 4; ++c) {
                const LAS unsigned char* vp = lds + VOFF + (16 * c + fr) * VROW + (32 * t + 4 * fq) * 2;
                const v2u lo = *(const LAS v2u*)vp, hi = *(const LAS v2u*)(vp + 32);
                const bf16x8 va = __builtin_bit_cast(bf16x8, (v4u){lo.x, lo.y, hi.x, hi.y});
                o[c] = __builtin_amdgcn_mfma_f32_16x16x32_bf16(va, pb, o[c], 0, 0, 0);
            }
        }
        const float inv = 1.0f / sum;
        bf16* op = cat + row * D + MW + h * 64 + 4 * fq;
#pragma unroll
        for (int c = 0; c < 4; ++c) *(v2u*)(op + 16 * c) = (v2u){pk2(o[c][0] * inv, o[c][1] * inv), pk2(o[c][2] * inv, o[c][3] * inv)};
    }
    __syncthreads();
}

#define UNPACK8(p, f) do { f[0] = bflo((p).x); f[1] = bfhi((p).x); f[2] = bflo((p).y); f[3] = bfhi((p).y); f[4] = bflo((p).z); f[5] = bfhi((p).z); f[6] = bflo((p).w); f[7] = bfhi((p).w); } while (0)
__device__ __forceinline__ void conv_mix(const bf16* z, const float* cw, bf16* cat, int gtid, int NGT) {
    for (int idx = gtid; idx < M * (MW / 8); idx += NGT) {
        const int row = idx / (MW / 8), c = idx % (MW / 8), t = row & (SEQ - 1);
        const bf16* zp = z + (size_t)row * LDZ0 + c * 8;
        const v4u pb = *(const v4u*)zp;
        v4u pu[3]; f32x4 w0[3], w1[3];
#pragma unroll
        for (int k = 0; k < 3; ++k) {
            const int dt = 2 - k, back = (t >= dt) ? dt : 0;
            pu[k] = *(const v4u*)(zp - (size_t)back * LDZ0 + MW);
            w0[k] = *(const f32x4*)(cw + k * MW + c * 8); w1[k] = *(const f32x4*)(cw + k * MW + c * 8 + 4);
        }
        float y[8], gb[8]; UNPACK8(pb, gb);
#pragma unroll
        for (int e = 0; e < 8; ++e) y[e] = 0.f;
#pragma unroll
        for (int k = 0; k < 3; ++k) {
            const float mk = (t >= 2 - k) ? 1.0f : 0.0f;
            float uu[8]; UNPACK8(pu[k], uu);
            const f32x4 a0 = w0[k] * mk, a1 = w1[k] * mk;
            y[0] += a0.x * uu[0]; y[1] += a0.y * uu[1]; y[2] += a0.z * uu[2]; y[3] += a0.w * uu[3];
            y[4] += a1.x * uu[4]; y[5] += a1.y * uu[5]; y[6] += a1.z * uu[6]; y[7] += a1.w * uu[7];
        }
        *(v4u*)(cat + (size_t)row * D + c * 8) = (v4u){pk2(gb[0] * y[0], gb[1] * y[1]), pk2(gb[2] * y[2], gb[3] * y[3]), pk2(gb[4] * y[4], gb[5] * y[5]), pk2(gb[6] * y[6], gb[7] * y[7])};
    }
}
template <int W> __device__ __forceinline__ void pool_item(const bf16* zp, int t, bf16* outp) {
    v4u p[W];
#pragma unroll
    for (int i = 0; i < W; ++i) { const int back = (i <= t) ? i : 0; p[i] = *(const v4u*)(zp - (size_t)back * NWIN1); }
    float a[8], p0[8]; UNPACK8(p[0], p0);
#pragma unroll
    for (int e = 0; e < 8; ++e) a[e] = p0[e];
#pragma unroll
    for (int i = 1; i < W; ++i) { float f[8]; UNPACK8(p[i], f); const float mk = (i <= t) ? 1.0f : 0.0f;
#pragma unroll
        for (int e = 0; e < 8; ++e) a[e] += f[e] * mk; }
    const int cnt = (t + 1) < W ? (t + 1) : W; const float ic = 1.0f / (float)cnt;
    *(v4u*)outp = (v4u){pk2(a[0] * ic - p0[0], a[1] * ic - p0[1]), pk2(a[2] * ic - p0[2], a[3] * ic - p0[3]), pk2(a[4] * ic - p0[4], a[5] * ic - p0[5]), pk2(a[6] * ic - p0[6], a[7] * ic - p0[7])};
}
__device__ __forceinline__ void pool_mix(const bf16* z, bf16* cat, int gtid, int NGT) {
    for (int idx = gtid; idx < M * (MW / 8); idx += NGT) {
        const int blk = idx / 192, rem = idx % 192, g = __builtin_amdgcn_readfirstlane(blk / (M / 8)), rb = blk % (M / 8);
        const int row = rb * 8 + rem / 24, c = g * 24 + rem % 24, t = row & (SEQ - 1);
        const bf16* zp = z + (size_t)row * NWIN1 + c * 8; bf16* op = cat + (size_t)row * D + c * 8;
        if (g == 0) pool_item<2>(zp, t, op); else if (g == 1) pool_item<4>(zp, t, op); else if (g == 2) pool_item<8>(zp, t, op); else pool_item<16>(zp, t, op);
    }
}

__global__ void __launch_bounds__(NWAVES * 64, 2) fwd_megakernel(Args a) {
    extern __shared__ __attribute__((aligned(16))) unsigned char lds_raw[];
    LAS unsigned char* lds = (LAS unsigned char*)lds_raw;
    cg::grid_group grid = cg::this_grid();
    const int G = gridDim.x, bx = blockIdx.x;
#define TID_VIEW() int tid = threadIdx.x; asm volatile("" : "+v"(tid)); const int lane = tid & 63, wave = __builtin_amdgcn_readfirstlane(tid >> 6); \
    const int gw = bx * NWAVES + wave, NGW = G * NWAVES, gtid = bx * (NWAVES * 64) + tid, NGT = G * NWAVES * 64; (void)lane; (void)gw; (void)NGW; (void)gtid; (void)NGT;
    unsigned char* ws = a.ws;
    float* ssq = (float*)(ws + WS_SSQ);
    bf16* XB = (bf16*)(ws + WS_XB); bf16* CAT = (bf16*)(ws + WS_CAT); bf16* ACT = (bf16*)(ws + WS_ACT); bf16* Z = ACT;

    if (threadIdx.x < 64) ((LAS unsigned*)(lds + MISC_OFF))[threadIdx.x] = 0u;
    __syncthreads();
    const XcdBarrier bar = xcd_barrier_post((unsigned*)(ws + WS_BAR), (volatile LAS unsigned*)(lds + MISC_OFF));
    grid.sync();
    for (int rep = 0; rep < ((PROBE & 1) ? 2 : 1); ++rep) { TID_VIEW(); prologue(a, lds, gw, NGW, wave, lane, gtid, NGT); }
    xcd_barrier(bar);

#pragma unroll 1
    for (int i = 0; i < 4; ++i) {
        const int l = i >> 1, isv = i & 1;
        const bf16* memn = (const bf16*)(ws + WS_MEMN) + (size_t)l * MROWS * D; const bf16* wkv = (const bf16*)(ws + WS_WKV + l * SZ_WKV);
        pg8::Gemm g{isv ? wkv + (size_t)256 * D : memn, isv ? memn : wkv, isv ? 256 : MROWS, isv ? MROWS : 256, D};
        pg8::StaticOrder S; S.init(g.M, g.N, G, (bx + G - 4 * i) % G);
        pg8::EpiBf16S E{isv ? (bf16*)(ws + WS_VT) + (size_t)l * 256 * MROWS : (bf16*)(ws + WS_KB) + (size_t)l * MROWS * 256, isv ? MROWS : 256, nullptr};
        pg8::gemm_phase<pg8::EpiBf16S, pg8::StaticOrder, K_ALIGN, K_SP2>(lds, (LAS float*)(lds + RS_OFF), g, S, E);
    }

#pragma unroll 1
    for (int step = 0; step < 14; ++step) {
        const int l = step / 7, s = step % 7;
        if (s == 0 || s == 5) {
            const int f = (s == 5) ? 1 : 0;
            pg8::Gemm g{XB, (const bf16*)(ws + WS_WGU + (2 * l + f) * SZ_WGU), M, 2 * FF, D};
            pg8::StaticOrder S; S.init(M, 2 * FF, G, bx);
            static_assert((F8_GU & ~F8_DOWN) == 0 && (F8_GU & 5) == 0, "an FP8 gate|up projection is only wired for FFN 2 (its e4m3 input copy comes from the W_out epilogue) and together with an FP8 down projection");
            if (f8_gu(2 * l + f)) {
                pg8::Gemm g8{(const bf16*)(ws + WS_XB8), g.Bt, M, 2 * FF, D / 2};
                pg8::EpiSwiglu88 E{ACT, ssq + (size_t)(3 * l + 2 * f) * M, FF};
                pg8::gemm_phase<pg8::EpiSwiglu88, pg8::StaticOrder, K_ALIGN, K_SP2>(lds, (LAS float*)(lds + RS_OFF), g8, S, E);
            } else if (f8_down(2 * l + f)) { pg8::EpiSwiglu8 E{ACT, ssq + (size_t)(3 * l + 2 * f) * M, FF};
                pg8::gemm_phase<pg8::EpiSwiglu8, pg8::StaticOrder, K_ALIGN, K_SP2>(lds, (LAS float*)(lds + RS_OFF), g, S, E);
            } else { pg8::EpiSwiglu E{ACT, ssq + (size_t)(3 * l + 2 * f) * M, FF};
                pg8::gemm_phase<pg8::EpiSwiglu, pg8::StaticOrder, K_ALIGN, K_SP2>(lds, (LAS float*)(lds + RS_OFF), g, S, E); }
#if (PROBE & 512)
            { struct FixedOrder : pg8::StaticOrder { __device__ bool next(int i, pg8::Unit& u) const { const long L = (long)i * G + c; if (L >= nwg) return false; u.pm = c % 8; u.pn = (c / 8) % 4; return true; } };
              FixedOrder SF; SF.init(M, 2 * FF, G, bx); pg8::EpiNull EN{(float*)(ws + 7 * MiB)}; pg8::gemm_phase<pg8::EpiNull, FixedOrder, K_ALIGN, K_SP2>(lds, (LAS float*)(lds + RS_OFF), g, SF, EN); }
#endif
#if (PROBE & 256)
            { pg8::EpiNull EN{(float*)(ws + 7 * MiB)}; pg8::gemm_phase<pg8::EpiNull, pg8::StaticOrder, K_ALIGN, K_SP2>(lds, (LAS float*)(lds + RS_OFF), g, S, EN); }
#endif
        } else if (s == 1 || s == 4 || s == 6) {
            const int f = (s == 6) ? 1 : 0; const bool isout = (s == 4);
            pg8::Gemm g{isout ? CAT : ACT, isout ? (const bf16*)(ws + WS_WOUT + l * SZ_WOUT) : (const bf16*)(ws + WS_WD + (2 * l + f) * SZ_WD), M, D, isout ? D : FF};
            pg8::StaticOrder S; S.init(M, D, G, bx);
#if (PROBE & 24)
            if (((PROBE & 8) && !isout) || ((PROBE & 16) && isout)) {
                pg8::EpiResid E0{(step == 1) ? a.in[0] : nullptr, isout ? ACT : CAT, (float*)(ws + 7 * MiB), isout ? 1.0f : 0.5f};
                pg8::gemm_phase<pg8::EpiResid, pg8::StaticOrder, K_ALIGN, K_SP2_RESID>(lds, (LAS float*)(lds + RS_OFF), g, S, E0); }
#endif
            if (!isout && f8_down(2 * l + f)) {
                pg8::Gemm g8{ACT, g.Bt, M, D, FF / 2};
                pg8::EpiResid8 E{(step == 1) ? a.in[0] : nullptr, XB, ssq + (size_t)(3 * l + 1 + 2 * f) * M, 0.5f / W8_SCALE};
                pg8::gemm_phase<pg8::EpiResid8, pg8::StaticOrder, K_ALIGN, K_SP2_RESID>(lds, (LAS float*)(lds + RS_OFF), g8, S, E);
            } else {
            if (isout && f8_gu(2 * l + 1)) {
                typedef pg8::EpiResidT<false, (long)(WS_XB8 - WS_XB)> EpiResidX8;
                EpiResidX8 E{nullptr, XB, ssq + (size_t)(3 * l + 2) * M, 1.0f};
                pg8::gemm_phase<EpiResidX8, pg8::StaticOrder, K_ALIGN, K_SP2_RESID>(lds, (LAS float*)(lds + RS_OFF), g, S, E);
            } else {
            pg8::EpiResid E{(step == 1) ? a.in[0] : nullptr, XB, ssq + (size_t)(3 * l + (isout ? 2 : 1 + 2 * f)) * M, isout ? 1.0f : 0.5f};
            pg8::gemm_phase<pg8::EpiResid, pg8::StaticOrder, K_ALIGN, K_SP2_RESID>(lds, (LAS float*)(lds + RS_OFF), g, S, E); } }
        } else if (s == 2) {
            const int N = l ? NWIN1 : NWIN0;
            pg8::Gemm g{XB, (const bf16*)(ws + (l ? WS_WIN1 : WS_WIN0)), M, N, D};
            pg8::StaticOrder S; S.init(M, N, G, bx);
            if (l == 0) { pg8::EpiWin0 E{Z, ssq + (size_t)(3 * l + 1) * M};
                pg8::gemm_phase<pg8::EpiWin0, pg8::StaticOrder, K_ALIGN, K_SP2>(lds, (LAS float*)(lds + RS_OFF), g, S, E);
            } else { pg8::EpiBf16S E{Z, N, ssq + (size_t)(3 * l + 1) * M};
                pg8::gemm_phase<pg8::EpiBf16S, pg8::StaticOrder, K_ALIGN, K_SP2>(lds, (LAS float*)(lds + RS_OFF), g, S, E); }
        } else {
            for (int rep = 0; rep < ((PROBE & 4) ? 2 : 1); ++rep) {
            TID_VIEW();
            const int ldz = l ? NWIN1 : LDZ0, qoff = l ? MW : 2 * MW;
            const bf16* Kb = (const bf16*)(ws + WS_KB) + (size_t)l * MROWS * 256; const bf16* Vt = (const bf16*)(ws + WS_VT) + (size_t)l * 256 * MROWS;
            for (int u = bx; u < NB * 4 * (SEQ / 512); u += G) { const int rp = u % (SEQ / 512), bh = u / (SEQ / 512);
                attn_unit(lds, Z, ldz, qoff, Kb, Vt, CAT, bh >> 2, bh & 3, 2 * rp, tid, lane, wave); }
            if (l == 0) conv_mix(Z, a.in[10], CAT, gtid, NGT); else pool_mix(Z, CAT, gtid, NGT);
            }
        }
        xcd_barrier(bar);
        if (PROBE & 64) xcd_barrier(bar);
    }
    for (int rep = 0; rep < ((PROBE & 128) ? 2 : 1); ++rep) { TID_VIEW(); const float* sq = ssq + (size_t)6 * M; const f32x4* gr = (const f32x4*)a.in[17] + lane * 2;
      const f32x4 g0 = gr[0], g1 = gr[1], g2 = gr[128], g3 = gr[129];
      for (int m0 = gw; m0 < M; m0 += 4 * NGW) {
        v4u p[4][2];
#pragma unroll
        for (int q = 0; q < 4; ++q) { const int m = m0 + q * NGW; const v4u* xr = (const v4u*)(XB + (size_t)(m < M ? m : m0) * D) + lane; p[q][0] = xr[0]; p[q][1] = xr[64]; }
#pragma unroll
        for (int q = 0; q < 4; ++q) { const int m = m0 + q * NGW; if (m < M) { const float r = pg8::rstd_of(sq, m); f32x4* orow = (f32x4*)(a.out + (size_t)m * D) + lane * 2;
            float f[8]; UNPACK8(p[q][0], f);
            orow[0] = (f32x4){f[0] * r * g0.x, f[1] * r * g0.y, f[2] * r * g0.z, f[3] * r * g0.w}; orow[1] = (f32x4){f[4] * r * g1.x, f[5] * r * g1.y, f[6] * r * g1.z, f[7] * r * g1.w};
            UNPACK8(p[q][1], f);
            orow[128] = (f32x4){f[0] * r * g2.x, f[1] * r * g2.y, f[2] * r * g2.z, f[3] * r * g2.w}; orow[129] = (f32x4){f[4] * r * g3.x, f[5] * r * g3.y, f[6] * r * g3.z, f[7] * r * g3.w}; } }
      } }
}

extern "C" void kernel_launch(void* const* d_in, const int* in_sizes, int n_in, void* d_out, int out_size, void* d_ws, size_t ws_size, hipStream_t stream) {
    static int grid = 0;
    if (grid == 0) {
        if (n_in != 18 || in_sizes[0] != M * D || out_size != M * D || ws_size < WS_END) { fprintf(stderr, "kernel_launch: unexpected shapes (n_in %d, in0 %d, out %d, ws %zu)\n", n_in, n_in > 0 ? in_sizes[0] : -1, out_size, ws_size); grid = -1; return; }
        int dev = 0, cus = 0, per_cu = 0;
        if (hipGetDevice(&dev) != hipSuccess || hipDeviceGetAttribute(&cus, hipDeviceAttributeMultiprocessorCount, dev) != hipSuccess) { grid = -1; return; }
        if (hipFuncSetAttribute((const void*)fwd_megakernel, hipFuncAttributeMaxDynamicSharedMemorySize, LDS_BYTES) != hipSuccess) { fprintf(stderr, "kernel_launch: hipFuncSetAttribute failed\n"); grid = -1; return; }
        if (hipOccupancyMaxActiveBlocksPerMultiprocessor(&per_cu, (const void*)fwd_megakernel, NWAVES * 64, LDS_BYTES) != hipSuccess || per_cu < 1) { fprintf(stderr, "kernel_launch: occupancy query says %d\n", per_cu); per_cu = 1; }
        (void)hipGetLastError();
        grid = cus * 1;
    }
    if (grid < 0) return;
    Args a{};
    for (int i = 0; i < 18; ++i) a.in[i] = (const float*)d_in[i];
    a.out = (float*)d_out; a.ws = (unsigned char*)d_ws;
    if (hipMemsetAsync((char*)d_ws + WS_BAR, 0, BAR_ZERO_BYTES, stream) != hipSuccess) { fprintf(stderr, "kernel_launch: memset failed\n"); return; }
    void* args[] = {&a};
    hipError_t e = hipLaunchCooperativeKernel((const void*)fwd_megakernel, dim3(grid), dim3(NWAVES * 64), args, LDS_BYTES, stream);
    if (e != hipSuccess) fprintf(stderr, "kernel_launch: cooperative launch failed: %s (grid %d)\n", hipGetErrorString(e), grid);
}
```

```cpp
#include <hip/hip_runtime.h>
#include <hip/hip_cooperative_groups.h>
#include <cstdio>
#include <cstdint>
namespace cg = cooperative_groups;
#ifndef PROBE
#define PROBE 0
#endif
#ifndef K_ALIGN
#define K_ALIGN true
#endif
#ifndef RELAX_EPI
#define RELAX_EPI false
#endif
#ifndef USE_PRE
#define USE_PRE true
#endif
#ifndef K_SP2_RESID
#define K_SP2_RESID K_SP2
#endif
#ifndef PG8_WGM
#define PG8_WGM 8
#endif
#ifndef K_SP2
#define K_SP2 true
#endif
namespace pg8 {
#define PG8_LAS __attribute__((address_space(3)))
typedef unsigned short bf16_t;
typedef short bf16x8 __attribute__((ext_vector_type(8)));
typedef float f32x4 __attribute__((ext_vector_type(4)));
typedef unsigned u32x4 __attribute__((ext_vector_type(4)));
typedef int v4i_t __attribute__((ext_vector_type(4)));
typedef unsigned u32x2 __attribute__((ext_vector_type(2)));
constexpr int BM = 256, BK = 64, HALF = 128, HTB = HALF * BK * 2  , STAGE_BYTES = 8 * HTB, NXCD = 8, WGM = PG8_WGM;

__host__ __device__ __forceinline__ int lds_byte(int r, int c) { const int st = (r >> 4) * 2 + (c >> 5), rr = r & 15, cc = c & 31, ob = rr * 64 + cc * 2; return st * 1024 + (ob ^ (((ob >> 9) & 1) << 5)); }
__host__ __device__ __forceinline__ void stage_rc(int b, int& R, int& C) { const int st = b / 1024, sb = b % 1024, swz = sb ^ (((sb >> 9) & 1) << 5); R = (st >> 1) * 16 + swz / 64; C = (st & 1) * 32 + (swz % 64) / 2; }
__host__ __device__ __forceinline__ int perm32(int rho) { const int n = rho >> 4, i = rho & 15; return 8 * (i >> 2) + 4 * n + (i & 3); }

struct Unit { int pm, pn; };
struct Gemm { const bf16_t* A; const bf16_t* Bt; int M, N, K; };

struct StaticOrder {
    int nM, nN, nwg, G, c; unsigned inv_nig;
    __host__ __device__ void init(int M, int N, int G_, int c_) { nM = M / BM; nN = N / BM; nwg = nM * nN; G = G_; c = c_; inv_nig = ((1u << 20) + (unsigned)(WGM * nN) - 1u) / (unsigned)(WGM * nN); }
    __host__ __device__ bool next(int i, Unit& u) const {
        const long L = (long)i * G + c; if (L >= nwg) return false;
        int wgid = (int)L; { const int q = nwg / NXCD, r = nwg % NXCD, xcd = wgid % NXCD, off = wgid / NXCD; wgid = (xcd < r ? xcd * (q + 1) : r * (q + 1) + (xcd - r) * q) + off; }
        const int nig = WGM * nN, gid = (int)(((unsigned)wgid * inv_nig) >> 20), rem = wgid - gid * nig, fm = gid * WGM, gsz = (nM - fm) < WGM ? (nM - fm) : WGM;
        if (gsz == WGM) { u.pm = fm + (rem & (WGM - 1)); u.pn = rem / WGM; }
        else { u.pm = fm + (rem % gsz); u.pn = rem / gsz; }
        return true;
    }
    __device__ __forceinline__ void a_ready(const Unit&) const {}
    __device__ __forceinline__ void done(const Unit&) const {}
};

__device__ __forceinline__ unsigned cvt_pk_bf16(float lo, float hi) { unsigned r; asm volatile("v_cvt_pk_bf16_f32 %0, %1, %2" : "=v"(r) : "v"(lo), "v"(hi)); return r; }
typedef float f32x2 __attribute__((ext_vector_type(2)));
constexpr float RMS_EPS = 1e-6f;
constexpr float SSQ_FX = 1024.0f;
__device__ __forceinline__ float rstd_from_bits(unsigned bits) { return __builtin_amdgcn_rsqf((float)bits * (1.0f / (1024.0f * SSQ_FX)) + RMS_EPS); }
__device__ __forceinline__ float rstd_of(const float* ssq, int row) { return rstd_from_bits(((const unsigned*)ssq)[row]); }

template <bool OUT8, bool IN8 = false> struct EpiSwigluT {
    static constexpr bool FP8 = IN8, PERM = true, AFTER_DRAIN = false, PRE = USE_PRE; static constexpr int NST = 8;
    bf16_t* O; const float* ssq; int ldo;
    __device__ __forceinline__ void operator()(const f32x4 (&acc)[2][2][4][2], const Unit& u, int wr, int wc, int fr, int fq, const PG8_LAS float* rs) const {
        const int row0 = u.pm * BM + wr * 64 + fr, col0 = u.pn * HALF + wc * 32 + 8 * fq;
        float rr[2][4];
#pragma unroll
        for (int ai = 0; ai < 2; ++ai)
#pragma unroll
            for (int m = 0; m < 4; ++m) rr[ai][m] = USE_PRE ? rs[wr * 64 + fr + ai * HALF + m * 16] : rstd_of(ssq, row0 + ai * HALF + m * 16);
#pragma unroll
        for (int ai = 0; ai < 2; ++ai)
#pragma unroll
            for (int m = 0; m < 4; ++m) {
                const int row = row0 + ai * HALF + m * 16;
                const float r = IN8 ? rr[ai][m] * (1.0f / 32.0f) : rr[ai][m];
                const float k1 = -1.4426950408889634f * r, r2 = r * r;
                unsigned w[4]; f32x2 hh[2][2];
#pragma unroll
                for (int n = 0; n < 2; ++n)
#pragma unroll
                    for (int j = 0; j < 2; ++j) {
                        const f32x2 gg = (f32x2){acc[ai][0][m][n][2 * j], acc[ai][0][m][n][2 * j + 1]}, uu = (f32x2){acc[ai][1][m][n][2 * j], acc[ai][1][m][n][2 * j + 1]};
                        const f32x2 x = gg * k1; f32x2 ex; ex.x = __builtin_amdgcn_exp2f(x.x); ex.y = __builtin_amdgcn_exp2f(x.y);
                        const f32x2 d = ex + 1.0f; f32x2 q; q.x = __builtin_amdgcn_rcpf(d.x); q.y = __builtin_amdgcn_rcpf(d.y);
                        const f32x2 h = ((gg * uu) * r2) * q;
                        if constexpr (!OUT8) w[2 * n + j] = cvt_pk_bf16(h.x, h.y);
                        else hh[n][j] = h;
                    }
                if constexpr (OUT8) {
#pragma unroll
                    for (int n = 0; n < 2; ++n) { int p = __builtin_amdgcn_cvt_pk_fp8_f32(hh[n][0].x, hh[n][0].y, 0, false); p = __builtin_amdgcn_cvt_pk_fp8_f32(hh[n][1].x, hh[n][1].y, p, true); w[n] = (unsigned)p; } }
                if constexpr (!OUT8) __builtin_nontemporal_store((u32x4){w[0], w[1], w[2], w[3]}, (u32x4*)(O + (size_t)row * ldo + col0));
                else __builtin_nontemporal_store((u32x2){w[0], w[1]}, (u32x2*)((unsigned char*)O + (size_t)row * ldo + col0));
            }
    }
};
template <bool IN8, long X8D = 0> struct EpiResidT {
    static constexpr bool FP8 = IN8, PERM = true, AFTER_DRAIN = false, PRE = false; static constexpr int NST = 24;
    const float* xin; bf16_t* xb; float* ssq; float s;
    __device__ __forceinline__ void finish_row(const f32x4 (&v)[2][2], int row, int col0, int fq) const {
        float sq = 0.f;
#pragma unroll
        for (int bj = 0; bj < 2; ++bj) {
            const f32x4 v0 = v[bj][0], v1 = v[bj][1];
            u32x4 w; w.x = cvt_pk_bf16(v0[0], v0[1]); w.y = cvt_pk_bf16(v0[2], v0[3]); w.z = cvt_pk_bf16(v1[0], v1[1]); w.w = cvt_pk_bf16(v1[2], v1[3]);
            *(u32x4*)(xb + (size_t)row * 1024 + col0 + bj * HALF) = w;
            if constexpr (X8D != 0) { int p0 = __builtin_amdgcn_cvt_pk_fp8_f32(v0[0], v0[1], 0, false); p0 = __builtin_amdgcn_cvt_pk_fp8_f32(v0[2], v0[3], p0, true);
                int p1 = __builtin_amdgcn_cvt_pk_fp8_f32(v1[0], v1[1], 0, false); p1 = __builtin_amdgcn_cvt_pk_fp8_f32(v1[2], v1[3], p1, true);
                *(u32x2*)((unsigned char*)xb + X8D + (size_t)row * 1024 + col0 + bj * HALF) = (u32x2){(unsigned)p0, (unsigned)p1}; }
            sq += (v0[0] * v0[0] + v0[1] * v0[1]) + (v0[2] * v0[2] + v0[3] * v0[3]) + (v1[0] * v1[0] + v1[1] * v1[1]) + (v1[2] * v1[2] + v1[3] * v1[3]);
        }
        sq += __shfl_xor(sq, 16); sq += __shfl_xor(sq, 32);
        if (fq == 0) (void)__hip_atomic_fetch_add((unsigned*)ssq + row, (unsigned)(sq * SSQ_FX + 0.5f), __ATOMIC_RELAXED, __HIP_MEMORY_SCOPE_AGENT);
    }
    __device__ __forceinline__ void operator()(const f32x4 (&acc)[2][2][4][2], const Unit& u, int wr, int wc, int fr, int fq, const PG8_LAS float*) const {
        const int row0 = u.pm * BM + wr * 64 + fr, col0 = u.pn * BM + wc * 32 + 8 * fq;
        if (xin) {
#pragma unroll
            for (int ai = 0; ai < 2; ++ai) {
                f32x4 x[4][2][2];
#pragma unroll
                for (int m = 0; m < 4; ++m)
#pragma unroll
                    for (int bj = 0; bj < 2; ++bj) { const float* p = xin + (size_t)(row0 + ai * HALF + m * 16) * 1024 + col0 + bj * HALF; x[m][bj][0] = *(const f32x4*)p; x[m][bj][1] = *(const f32x4*)(p + 4); }
#pragma unroll
                for (int m = 0; m < 4; ++m) { f32x4 v[2][2];
#pragma unroll
                    for (int bj = 0; bj < 2; ++bj) { v[bj][0] = x[m][bj][0] + acc[ai][bj][m][0] * s; v[bj][1] = x[m][bj][1] + acc[ai][bj][m][1] * s; }
                    finish_row(v, row0 + ai * HALF + m * 16, col0, fq); }
            }
        } else {
            u32x4 p[2][4][2];
#pragma unroll
            for (int ai = 0; ai < 2; ++ai)
#pragma unroll
                for (int m = 0; m < 4; ++m)
#pragma unroll
                    for (int bj = 0; bj < 2; ++bj) p[ai][m][bj] = *(const u32x4*)(xb + (size_t)(row0 + ai * HALF + m * 16) * 1024 + col0 + bj * HALF);
#pragma unroll
            for (int ai = 0; ai < 2; ++ai)
#pragma unroll
                for (int m = 0; m < 4; ++m) { f32x4 v[2][2];
#pragma unroll
                    for (int bj = 0; bj < 2; ++bj) { const u32x4 q = p[ai][m][bj];
                        const f32x4 x0 = (f32x4){__uint_as_float(q.x << 16), __uint_as_float(q.x & 0xffff0000u), __uint_as_float(q.y << 16), __uint_as_float(q.y & 0xffff0000u)};
                        const f32x4 x1 = (f32x4){__uint_as_float(q.z << 16), __uint_as_float(q.z & 0xffff0000u), __uint_as_float(q.w << 16), __uint_as_float(q.w & 0xffff0000u)};
                        v[bj][0] = x0 + acc[ai][bj][m][0] * s; v[bj][1] = x1 + acc[ai][bj][m][1] * s; }
                    finish_row(v, row0 + ai * HALF + m * 16, col0, fq); }
        }
    }
};
struct EpiBf16S {
    static constexpr bool FP8 = false, PERM = true, AFTER_DRAIN = false, PRE = USE_PRE; static constexpr int NST = 16;
    bf16_t* O; int ldc; const float* ssq;
    __device__ __forceinline__ void operator()(const f32x4 (&acc)[2][2][4][2], const Unit& u, int wr, int wc, int fr, int fq, const PG8_LAS float* rs) const {
        const int row0 = u.pm * BM + wr * 64 + fr, col0 = u.pn * BM + wc * 32 + 8 * fq;
        float rr[2][4];
#pragma unroll
        for (int ai = 0; ai < 2; ++ai)
#pragma unroll
            for (int m = 0; m < 4; ++m) rr[ai][m] = USE_PRE ? rs[wr * 64 + fr + ai * HALF + m * 16] : (ssq ? rstd_of(ssq, row0 + ai * HALF + m * 16) : 1.0f);
#pragma unroll
        for (int ai = 0; ai < 2; ++ai)
#pragma unroll
            for (int m = 0; m < 4; ++m) {
                const int row = row0 + ai * HALF + m * 16;
                const float r = rr[ai][m];
#pragma unroll
                for (int bj = 0; bj < 2; ++bj) {
                    const f32x4 v0 = acc[ai][bj][m][0] * r, v1 = acc[ai][bj][m][1] * r;
                    u32x4 w; w.x = cvt_pk_bf16(v0[0], v0[1]); w.y = cvt_pk_bf16(v0[2], v0[3]); w.z = cvt_pk_bf16(v1[0], v1[1]); w.w = cvt_pk_bf16(v1[2], v1[3]);
                    *(u32x4*)(O + (size_t)row * ldc + col0 + bj * HALF) = w;
                }
            }
    }
};
struct EpiWin0 {
    static constexpr bool FP8 = false, PERM = true, AFTER_DRAIN = false, PRE = USE_PRE; static constexpr int NST = 8;
    bf16_t* O; const float* ssq;
    __device__ __forceinline__ void operator()(const f32x4 (&acc)[2][2][4][2], const Unit& u, int wr, int wc, int fr, int fq, const PG8_LAS float* rs) const {
        const int row0 = u.pm * BM + wr * 64 + fr;
        float rr[2][4];
#pragma unroll
        for (int ai = 0; ai < 2; ++ai)
#pragma unroll
            for (int m = 0; m < 4; ++m) rr[ai][m] = USE_PRE ? rs[wr * 64 + fr + ai * HALF + m * 16] : rstd_of(ssq, row0 + ai * HALF + m * 16);
        if (u.pn >= 3 && u.pn < 9) {
            const int col0 = 768 + (u.pn - 3) * HALF + wc * 32 + 8 * fq;
#pragma unroll
            for (int ai = 0; ai < 2; ++ai)
#pragma unroll
                for (int m = 0; m < 4; ++m) { const float r2 = rr[ai][m] * rr[ai][m];
                    const f32x4 v0 = acc[ai][0][m][0] * acc[ai][1][m][0] * r2, v1 = acc[ai][0][m][1] * acc[ai][1][m][1] * r2;
                    u32x4 w; w.x = cvt_pk_bf16(v0[0], v0[1]); w.y = cvt_pk_bf16(v0[2], v0[3]); w.z = cvt_pk_bf16(v1[0], v1[1]); w.w = cvt_pk_bf16(v1[2], v1[3]);
                    *(u32x4*)(O + (size_t)(row0 + ai * HALF + m * 16) * 1792 + col0) = w; }
        } else {
            const int col0 = (u.pn < 3 ? u.pn * BM : 1536) + wc * 32 + 8 * fq;
#pragma unroll
            for (int ai = 0; ai < 2; ++ai)
#pragma unroll
                for (int m = 0; m < 4; ++m) { const float r = rr[ai][m];
#pragma unroll
                    for (int bj = 0; bj < 2; ++bj) { const f32x4 v0 = acc[ai][bj][m][0] * r, v1 = acc[ai][bj][m][1] * r;
                        u32x4 w; w.x = cvt_pk_bf16(v0[0], v0[1]); w.y = cvt_pk_bf16(v0[2], v0[3]); w.z = cvt_pk_bf16(v1[0], v1[1]); w.w = cvt_pk_bf16(v1[2], v1[3]);
                        *(u32x4*)(O + (size_t)(row0 + ai * HALF + m * 16) * 1792 + col0 + bj * HALF) = w; } }
        }
    }
};
struct EpiNull {
    static constexpr bool FP8 = false, PERM = true, AFTER_DRAIN = false, PRE = false; static constexpr int NST = 0;
    float* sink;
    __device__ __forceinline__ void operator()(const f32x4 (&acc)[2][2][4][2], const Unit& u, int wr, int wc, int fr, int fq, const PG8_LAS float*) const {
        float t = 0.f;
#pragma unroll
        for (int ai = 0; ai < 2; ++ai)
#pragma unroll
            for (int bj = 0; bj < 2; ++bj)
#pragma unroll
                for (int m = 0; m < 4; ++m)
#pragma unroll
                    for (int n = 0; n < 2; ++n) t += (acc[ai][bj][m][n][0] + acc[ai][bj][m][n][1]) + (acc[ai][bj][m][n][2] + acc[ai][bj][m][n][3]);
        if (t == 123456.78125f) sink[u.pm * 256 + fr] = t;
    }
};
typedef EpiSwigluT<false> EpiSwiglu; typedef EpiSwigluT<true> EpiSwiglu8; typedef EpiSwigluT<true, true> EpiSwiglu88; typedef EpiSwigluT<false, true> EpiSwiglu08; typedef EpiResidT<false> EpiResid; typedef EpiResidT<true> EpiResid8;
template <class Epi, class Sched, bool ALIGN_EPI = false, bool SP2 = false>
__device__ __forceinline__ void gemm_phase(PG8_LAS unsigned char* lds, PG8_LAS float* rs, const Gemm g, const Sched& S, const Epi& E) {
    int tid = threadIdx.x; asm volatile("" : "+v"(tid));
    const int wid = __builtin_amdgcn_readfirstlane(tid >> 6), lane = tid & 63, wr = wid >> 2, wc = wid & 3, fr = lane & 15, fq = lane >> 4;
    const int K = g.K, nt = K / BK;
    unsigned voffA, voffB;
    { int R, C; stage_rc(tid * 16, R, C); const int Rb = Epi::PERM ? ((R & ~31) + perm32(R & 31)) : R;
        voffA = (unsigned)(R * K + C) * 2u; voffB = (unsigned)(Rb * K + C) * 2u; }
    const size_t qstep = (size_t)64 * K * 2;
    const size_t kstep = (size_t)(BK * 2);
    const size_t hstep = (size_t)HALF * K * 2;
    const size_t tstep = 2 * hstep;
    const unsigned ldsw = (unsigned)wid * 1024u;
    const int aoff = lds_byte(wr * 64 + fr, fq * 8), boff = lds_byte(wc * 32 + fr, fq * 8);
#define PG8_SA(b, h) (((b) * 2 + (h)) * HTB)
#define PG8_SB(b, h) ((4 + (b) * 2 + (h)) * HTB)
#define PG8_STAGE(bufoff, gbase, voff) do { _Pragma("unroll") for (int _i = 0; _i < 2; ++_i) \
        __builtin_amdgcn_global_load_lds((const unsigned*)((const char*)(gbase) + _i * qstep + (voff)), (PG8_LAS unsigned*)(lds + (bufoff) + ldsw + _i * 8192), 16, 0, 0); } while (0)
#define PG8_LDA(dst, b, h) do { _Pragma("unroll") for (int m = 0; m < 4; ++m) _Pragma("unroll") for (int k = 0; k < 2; ++k) dst[m][k] = *(const PG8_LAS bf16x8*)(lds + PG8_SA(b, h) + aoff + m * 2048 + k * 1024); } while (0)
#define PG8_LDB(dst, b, h) do { _Pragma("unroll") for (int n = 0; n < 2; ++n) _Pragma("unroll") for (int k = 0; k < 2; ++k) dst[n][k] = *(const PG8_LAS bf16x8*)(lds + PG8_SB(b, h) + boff + n * 2048 + k * 1024); } while (0)
#define PG8_CAT8(x, y) __builtin_shufflevector(__builtin_bit_cast(v4i_t, (x)), __builtin_bit_cast(v4i_t, (y)), 0, 1, 2, 3, 4, 5, 6, 7)
#define PG8_MMA(ai, bj, At, Bt) do { __builtin_amdgcn_s_setprio(1); \
        if constexpr (Epi::FP8) {   \
            _Pragma("unroll") for (int m = 0; m < 4; ++m) _Pragma("unroll") for (int n = 0; n < 2; ++n) \
                asm volatile("v_mfma_scale_f32_16x16x128_f8f6f4 %0, %1, %2, %0, %3, %3 op_sel_hi:[0,0,0]" : "+v"(acc[ai][bj][m][n]) : "v"(PG8_CAT8(Bt[n][0], Bt[n][1])), "v"(PG8_CAT8(At[m][0], At[m][1])), "v"(sc8));   \
        } else { \
            _Pragma("unroll") for (int m = 0; m < 4; ++m) _Pragma("unroll") for (int n = 0; n < 2; ++n) _Pragma("unroll") for (int k = 0; k < 2; ++k) \
                acc[ai][bj][m][n] = __builtin_amdgcn_mfma_f32_16x16x32_bf16(Bt[n][k], At[m][k], acc[ai][bj][m][n], 0, 0, 0); } \
        __builtin_amdgcn_s_setprio(0); } while (0)
#define PG8_WAIT_V(n) asm volatile("s_waitcnt vmcnt(" #n ")" ::: "memory")
#define PG8_WAIT_VN(N) asm volatile("s_waitcnt vmcnt(%0)" :: "n"(N) : "memory")
#define PG8_WAIT_L(n) asm volatile("s_waitcnt lgkmcnt(" #n ")" ::: "memory")
#define PG8_BAR __builtin_amdgcn_s_barrier()
#define PG8_SCHED __builtin_amdgcn_sched_barrier(0)
    Unit cur, nxt; int ui = 0;
    if (!S.next(0, cur)) return;
    f32x4 acc[2][2][4][2];
#pragma unroll
    for (int a = 0; a < 2; ++a)
#pragma unroll
        for (int b = 0; b < 2; ++b)
#pragma unroll
            for (int m = 0; m < 4; ++m)
#pragma unroll
                for (int n = 0; n < 2; ++n) acc[a][b][m][n] = (f32x4){0.f, 0.f, 0.f, 0.f};
    bf16x8 At[4][2], B0[2][2], B1[2][2];
    const unsigned sc8 = 0x7f7f7f7fu; (void)sc8;
    const char* cA = (const char*)g.A + (size_t)cur.pm * tstep; const char* cB = (const char*)g.Bt + (size_t)cur.pn * tstep;
    S.a_ready(cur);
    float pre = 1.0f;
#define PG8_PRELOAD(u) do { if constexpr (Epi::PRE) { if (E.ssq) { const float* _p = E.ssq + (u).pm * BM + (tid & (BM - 1)); asm volatile("global_load_dword %0, %1, off" : "=v"(pre) : "v"(_p) : "memory"); } } } while (0)
    PG8_PRELOAD(cur);
    if constexpr (SP2) {
        PG8_STAGE(PG8_SB(0, 0), cB, voffB); PG8_STAGE(PG8_SB(0, 1), cB + hstep, voffB); PG8_STAGE(PG8_SA(0, 0), cA, voffA); PG8_STAGE(PG8_SA(0, 1), cA + hstep, voffA);
        if (wr == 1) PG8_BAR;
        PG8_WAIT_V(2); PG8_BAR;
        PG8_STAGE(PG8_SB(1, 0), cB + kstep, voffB); PG8_STAGE(PG8_SA(1, 0), cA + kstep, voffA); PG8_STAGE(PG8_SB(1, 1), cB + hstep + kstep, voffB);
        PG8_WAIT_V(6); PG8_BAR;
    } else {
        PG8_STAGE(PG8_SB(0, 0), cB, voffB); PG8_STAGE(PG8_SA(0, 0), cA, voffA); PG8_STAGE(PG8_SB(0, 1), cB + hstep, voffB); PG8_STAGE(PG8_SA(0, 1), cA + hstep, voffA);
        if (wr == 1) PG8_BAR;
        PG8_WAIT_V(4); PG8_BAR;
        PG8_STAGE(PG8_SB(1, 0), cB + kstep, voffB); PG8_STAGE(PG8_SA(1, 0), cA + kstep, voffA); PG8_STAGE(PG8_SB(1, 1), cB + hstep + kstep, voffB);
        PG8_WAIT_V(6); PG8_BAR;
    }
    for (;;) {
        const bool has_next = S.next(ui + 1, nxt);
        const char* nA = has_next ? (const char*)g.A + (size_t)nxt.pm * tstep : cA; const char* nB = has_next ? (const char*)g.Bt + (size_t)nxt.pn * tstep : cB;
        for (int t = 0; t < nt; t += 2) {
            const bool last = (t == nt - 2);
            const bool relax = RELAX_EPI && (t == 0) && (ui > 0);
            const char* a1 = cA + (size_t)(t + 1) * kstep;
            const char* a2 = last ? nA : cA + (size_t)(t + 2) * kstep; const char* b2 = last ? nB : cB + (size_t)(t + 2) * kstep;
            const char* a3 = a2 + kstep; const char* b3 = b2 + kstep;
            if (last && has_next) S.a_ready(nxt);
            if constexpr (SP2) {
            PG8_LDB(B0, 0, 0); PG8_LDB(B1, 0, 1); PG8_SCHED; PG8_LDA(At, 0, 0); PG8_STAGE(PG8_SA(1, 1), a1 + hstep, voffA);
            if (relax) PG8_WAIT_VN(8 + Epi::NST); else PG8_WAIT_V(8); PG8_WAIT_L(0); PG8_BAR; PG8_MMA(0, 0, At, B0); PG8_MMA(0, 1, At, B1); PG8_BAR; PG8_SCHED;
            PG8_LDA(At, 0, 1); PG8_STAGE(PG8_SB(0, 0), b2, voffB); PG8_STAGE(PG8_SB(0, 1), b2 + hstep, voffB); PG8_STAGE(PG8_SA(0, 0), a2, voffA);
            if (relax) PG8_WAIT_VN(8 + Epi::NST); else PG8_WAIT_V(8); PG8_WAIT_L(0); PG8_BAR; PG8_MMA(1, 0, At, B0); PG8_MMA(1, 1, At, B1); PG8_BAR; PG8_SCHED;
            PG8_LDB(B0, 1, 0); PG8_LDB(B1, 1, 1); PG8_SCHED; PG8_LDA(At, 1, 0); PG8_STAGE(PG8_SA(0, 1), a2 + hstep, voffA);
            PG8_WAIT_V(8); PG8_WAIT_L(0); PG8_BAR; PG8_MMA(0, 0, At, B0); PG8_MMA(0, 1, At, B1); PG8_BAR; PG8_SCHED;
            PG8_LDA(At, 1, 1); PG8_STAGE(PG8_SB(1, 0), b3, voffB); PG8_STAGE(PG8_SB(1, 1), b3 + hstep, voffB); PG8_STAGE(PG8_SA(1, 0), a3, voffA);
            PG8_WAIT_V(8); PG8_WAIT_L(0); PG8_BAR; PG8_MMA(1, 0, At, B0); PG8_MMA(1, 1, At, B1); PG8_BAR; PG8_SCHED;
            } else {
            PG8_LDB(B0, 0, 0); PG8_SCHED; PG8_LDA(At, 0, 0); PG8_STAGE(PG8_SA(1, 1), a1 + hstep, voffA);
            PG8_WAIT_L(8); PG8_BAR; PG8_WAIT_L(0); PG8_MMA(0, 0, At, B0); PG8_BAR; PG8_SCHED;
            PG8_LDB(B1, 0, 1); PG8_STAGE(PG8_SB(0, 0), b2, voffB);
            PG8_BAR; PG8_WAIT_L(0); PG8_MMA(0, 1, At, B1); PG8_BAR;
            PG8_LDA(At, 0, 1); PG8_STAGE(PG8_SA(0, 0), a2, voffA);
            PG8_BAR; PG8_WAIT_L(0); PG8_MMA(1, 0, At, B0); PG8_BAR; PG8_SCHED;
            PG8_STAGE(PG8_SB(0, 1), b2 + hstep, voffB);
            PG8_WAIT_V(6); PG8_BAR; PG8_MMA(1, 1, At, B1); PG8_BAR;
            PG8_LDB(B0, 1, 0); PG8_SCHED; PG8_LDA(At, 1, 0); PG8_STAGE(PG8_SA(0, 1), a2 + hstep, voffA);
            PG8_WAIT_L(8); PG8_BAR; PG8_WAIT_L(0); PG8_MMA(0, 0, At, B0); PG8_BAR; PG8_SCHED;
            PG8_LDB(B1, 1, 1); PG8_STAGE(PG8_SB(1, 0), b3, voffB);
            PG8_BAR; PG8_WAIT_L(0); PG8_MMA(0, 1, At, B1); PG8_BAR;
            PG8_LDA(At, 1, 1); PG8_STAGE(PG8_SA(1, 0), a3, voffA);
            PG8_BAR; PG8_WAIT_L(0); PG8_MMA(1, 0, At, B0); PG8_BAR; PG8_SCHED;
            PG8_STAGE(PG8_SB(1, 1), b3 + hstep, voffB);
            PG8_WAIT_V(6); PG8_BAR; PG8_MMA(1, 1, At, B1); PG8_BAR;
            }
        }
        if constexpr (ALIGN_EPI && Epi::PRE) {
            if (wr == 0) { rs[tid] = E.ssq ? rstd_from_bits(__float_as_uint(pre)) : 1.0f; PG8_WAIT_L(0); PG8_BAR; }
            asm volatile("" ::: "memory");
        } else {
        if constexpr (ALIGN_EPI) { if (wr == 0) PG8_BAR; }
        if constexpr (Epi::PRE) {
            if (tid < BM) rs[tid] = E.ssq ? rstd_from_bits(__float_as_uint(pre)) : 1.0f;
            PG8_WAIT_L(0); PG8_BAR; asm volatile("" ::: "memory");
        }
        }
        if constexpr (!Epi::AFTER_DRAIN) { E(acc, cur, wr, wc, fr, fq, rs); S.done(cur); }
        if (!has_next) break;
#pragma unroll
        for (int a = 0; a < 2; ++a)
#pragma unroll
            for (int b = 0; b < 2; ++b)
#pragma unroll
                for (int m = 0; m < 4; ++m)
#pragma unroll
                    for (int n = 0; n < 2; ++n) acc[a][b][m][n] = (f32x4){0.f, 0.f, 0.f, 0.f};
        cur = nxt; cA = nA; cB = nB; ++ui;
        PG8_PRELOAD(cur);
        if constexpr (ALIGN_EPI) { if (wr == 1) PG8_BAR; }
    }
    PG8_WAIT_V(0);
    if constexpr (!ALIGN_EPI) { if (wr == 0) PG8_BAR; }
    PG8_BAR;
    if constexpr (Epi::AFTER_DRAIN) { E.fused(acc, cur, wr, wc, fr, fq, lds, wid, lane); S.done(cur); }
#undef PG8_PRELOAD
#undef PG8_SA
#undef PG8_SB
#undef PG8_STAGE
#undef PG8_LDA
#undef PG8_LDB
#undef PG8_MMA
#undef PG8_CAT8
#undef PG8_WAIT_V
#undef PG8_WAIT_L
#undef PG8_WAIT_VN
#undef PG8_BAR
#undef PG8_SCHED
}
}
constexpr int NWAVES = 8;
#ifndef F8MASK
#define F8MASK 12
#endif
constexpr int F8_DOWN = F8MASK;
#ifndef F8GU
#define F8GU 8
#endif
constexpr int F8_GU = F8GU;
constexpr float GU8_SCALE = 32.0f;
__device__ __forceinline__ bool f8_gu(int idx) { return ((F8_GU >> idx) & 1) != 0; }
constexpr float W8_SCALE = 64.0f;
__device__ __forceinline__ bool f8_down(int idx) { return F8_DOWN == 15 ? true : (F8_DOWN == 0 ? false : ((F8_DOWN >> idx) & 1) != 0); }
constexpr int NB = 4, SEQ = 8192, D = 1024, FF = 2816, M = NB * SEQ, NMEM = 256, MW = 768, XW = 256, MROWS = NB * NMEM;
constexpr int NWIN0 = 3 * MW + XW, NWIN1 = MW + XW, PG = 192, LDZ0 = 2 * MW + XW;
constexpr size_t MiB = 1u << 20;
constexpr size_t WS_SSQ = 0;
constexpr size_t WS_BAR = 896 * 1024, BAR_ZERO_BYTES = 16 * 1024;
constexpr size_t WS_KB = 1 * MiB;
constexpr size_t WS_VT = 2 * MiB;
constexpr size_t WS_MEMN = 3 * MiB;
constexpr size_t WS_WGU = 8 * MiB, SZ_WGU = 11 * MiB;
constexpr size_t WS_WD = 52 * MiB, SZ_WD = (size_t)D * FF * 2;
constexpr size_t WS_WOUT = 74 * MiB, SZ_WOUT = 2 * MiB;
constexpr size_t WS_WKV = 78 * MiB, SZ_WKV = 1 * MiB;
constexpr size_t WS_WIN0 = 80 * MiB, WS_WIN1 = 85 * MiB;
constexpr size_t WS_XB = 88 * MiB;
constexpr size_t WS_CAT = 152 * MiB;
constexpr size_t WS_ACT = 216 * MiB;
constexpr size_t WS_XB8 = 392 * MiB;
constexpr size_t WS_END = 424 * MiB;
static_assert(WS_WD + 4 * SZ_WD <= WS_WOUT && WS_WIN0 + (size_t)NWIN0 * D * 2 <= WS_WIN1 && WS_WIN1 + 2 * MiB <= WS_XB, "ws map");
constexpr int MISC_OFF = 131072, RS_OFF = 131072 + 256, LDS_BYTES = 131072 + 256 + 1024;

#define GAS __attribute__((address_space(1)))
#define LAS __attribute__((address_space(3)))
typedef unsigned short bf16;
typedef unsigned v4u __attribute__((ext_vector_type(4)));
typedef unsigned v2u __attribute__((ext_vector_type(2)));
typedef float f32x4 __attribute__((ext_vector_type(4)));
typedef short bf16x8 __attribute__((ext_vector_type(8)));
#define LDS_WAIT() asm volatile("s_waitcnt lgkmcnt(0)" ::: "memory")
__device__ __forceinline__ unsigned pk2(float lo, float hi) { return pg8::cvt_pk_bf16(lo, hi); }
__device__ __forceinline__ float bflo(unsigned p) { return __uint_as_float(p << 16); }
__device__ __forceinline__ float bfhi(unsigned p) { return __uint_as_float(p & 0xffff0000u); }
__device__ __forceinline__ float wave_sum(float v) {
#pragma unroll
    for (int o = 1; o < 64; o <<= 1) v += __shfl_xor(v, o);
    return v;
}
#define XB_TMO      128
#define XB_XCNT(j)  (256  + 64 * (j))
#define XB_XSUB(j)  (1280 + 64 * (j))
#define XB_XGEN(j)  (2304 + 64 * (j))
#define XB_TOP      3328
#define XB_TOPGEN   3392
#define XCD_BAR_WORDS 3456
#define XB_SPIN_CAP (1u << 18)

__device__ __forceinline__ unsigned xb_ld(unsigned* p)              { return __hip_atomic_load(p, __ATOMIC_RELAXED, __HIP_MEMORY_SCOPE_AGENT); }
__device__ __forceinline__ unsigned xb_add(unsigned* p, unsigned v) { return __hip_atomic_fetch_add(p, v, __ATOMIC_RELAXED, __HIP_MEMORY_SCOPE_AGENT); }
__device__ __forceinline__ unsigned xb_xcc_id() { return (unsigned)__builtin_amdgcn_s_getreg((3 << 11) | 20) & 0xFu; }
#define XB_SPIN(cond, bar) do { unsigned _sp = 0; while (cond) { __builtin_amdgcn_s_sleep(1); \
    if ((++_sp & 255u) == 0u) { if (xb_ld(&(bar)[XB_TMO])) break; if (_sp > XB_SPIN_CAP) { atomicAdd(&(bar)[XB_TMO], 1u); break; } } } } while (0)

struct XcdBarrier {
    unsigned* bar; unsigned x;
    volatile LAS unsigned* st;
};

__device__ __forceinline__ XcdBarrier xcd_barrier_post(unsigned* bar, volatile LAS unsigned* st) {
    XcdBarrier b; b.bar = bar; b.x = xb_xcc_id(); b.st = st;
    if (threadIdx.x == 0) (void)xb_add(&bar[XB_XCNT(b.x)], 1u);
    return b;
}
__device__ __forceinline__ void xcd_barrier_complete(unsigned* bar, unsigned x, unsigned& nloc, unsigned& nx) {
    const unsigned G = gridDim.x * gridDim.y * gridDim.z;
    unsigned sum, cnt, mine, sp = 0u;
    for (;;) {
        sum = 0u; cnt = 0u; mine = 0u;
#pragma unroll
        for (unsigned j = 0; j < 16; ++j) { const unsigned c = xb_ld(&bar[XB_XCNT(j)]); sum += c; cnt += (c > 0u) ? 1u : 0u; mine = (j == x) ? c : mine; }
        if (sum == G) break;
        __builtin_amdgcn_s_sleep(1);
        if ((++sp & 255u) == 0u) { if (xb_ld(&bar[XB_TMO])) break; if (sp > XB_SPIN_CAP) { atomicAdd(&bar[XB_TMO], 1u); break; } }
    }
    nloc = mine > 0u ? mine : 1u; nx = cnt > 0u ? cnt : 1u;
}

__device__ __forceinline__ void xcd_barrier(const XcdBarrier& b) {
    asm volatile("s_waitcnt vmcnt(0)" ::: "memory");
    __syncthreads();
    if (threadIdx.x == 0) {
        unsigned* bar = b.bar;
        __builtin_amdgcn_s_waitcnt(0);
        unsigned nloc = b.st[0], nx = b.st[1];
        if (nloc == 0u) { xcd_barrier_complete(bar, b.x, nloc, nx); b.st[0] = nloc; b.st[1] = nx; }
        const unsigned old = xb_add(&bar[XB_XSUB(b.x)], 1u);
        const unsigned gen = old / nloc;
        if (old + 1u == (gen + 1u) * nloc) {
            __builtin_amdgcn_fence(__ATOMIC_RELEASE, "agent");
            asm volatile("s_waitcnt vmcnt(0)" ::: "memory");
            const unsigned og = xb_add(&bar[XB_TOP], 1u);
            const unsigned tg = og / nx;
            if (og + 1u == (tg + 1u) * nx) xb_add(&bar[XB_TOPGEN], 1u);
            else XB_SPIN(xb_ld(&bar[XB_TOPGEN]) == tg, bar);
            __builtin_amdgcn_fence(__ATOMIC_ACQUIRE, "agent");
            xb_add(&bar[XB_XGEN(b.x)], 1u);
            asm volatile("s_waitcnt vmcnt(0)" ::: "memory");
        } else {
            XB_SPIN(xb_ld(&bar[XB_XGEN(b.x)]) == gen, bar);
            __builtin_amdgcn_fence(__ATOMIC_ACQUIRE, "agent");
            asm volatile("s_waitcnt vmcnt(0)" ::: "memory");
        }
    }
    __syncthreads();
}


struct Args { const float* in[18]; float* out; unsigned char* ws; };

__device__ __forceinline__ void tr_item(const float* W, int N, const float* gain, bf16* WT, int ldk, int koff, int mode, LAS float* scr, int item, int lane, float scale8 = 0.f) {
    const int nblk = N / 32, kb = item / nblk, nb = item % nblk, k0 = 64 * kb, n0 = 32 * nb;
    f32x4 g0 = (f32x4){1.f, 1.f, 1.f, 1.f}, g1 = g0;
    if (gain) { g0 = *(const f32x4*)(gain + k0 + 8 * (lane & 7)); g1 = *(const f32x4*)(gain + k0 + 8 * (lane & 7) + 4); }
    { float v[32];
#pragma unroll
    for (int i = 0; i < 32; ++i) { const int kk = 2 * i + (lane >> 5); v[i] = __builtin_nontemporal_load(W + (size_t)(k0 + kk) * N + n0 + (lane & 31)); }
#pragma unroll
    for (int i = 0; i < 32; ++i) scr[(2 * i + (lane >> 5)) * 33 + (lane & 31)] = v[i]; }
    LDS_WAIT(); asm volatile("" ::: "memory");
    int d0 = n0;
    if (mode == 1) { const int half = n0 >= FF ? 1 : 0, j0 = n0 - half * FF; d0 = 256 * (j0 >> 7) + 128 * half + (j0 & 127); }
    if (mode == 2 && n0 >= MW && n0 < 3 * MW) { const int half = n0 >= 2 * MW ? 1 : 0, j0 = n0 - MW - half * MW; d0 = MW + 256 * (j0 >> 7) + 128 * half + (j0 & 127); }
    const int c = lane & 7;
#pragma unroll
    for (int j = 0; j < 4; ++j) { const int n = (lane >> 3) + 8 * j; const LAS float* s = scr + (8 * c) * 33 + n;
        if (scale8 != 0.f) {
            const f32x4 h0 = g0 * scale8, h1 = g1 * scale8; int lo = 0, hi = 0;
            lo = __builtin_amdgcn_cvt_pk_fp8_f32(s[0 * 33] * h0.x, s[1 * 33] * h0.y, lo, false); lo = __builtin_amdgcn_cvt_pk_fp8_f32(s[2 * 33] * h0.z, s[3 * 33] * h0.w, lo, true);
            hi = __builtin_amdgcn_cvt_pk_fp8_f32(s[4 * 33] * h1.x, s[5 * 33] * h1.y, hi, false); hi = __builtin_amdgcn_cvt_pk_fp8_f32(s[6 * 33] * h1.z, s[7 * 33] * h1.w, hi, true);
            *(v2u*)((unsigned char*)WT + (size_t)(d0 + n) * ldk + koff + k0 + 8 * c) = (v2u){(unsigned)lo, (unsigned)hi};
        } else {
        v4u o; o.x = pk2(s[0 * 33] * g0.x, s[1 * 33] * g0.y); o.y = pk2(s[2 * 33] * g0.z, s[3 * 33] * g0.w); o.z = pk2(s[4 * 33] * g1.x, s[5 * 33] * g1.y); o.w = pk2(s[6 * 33] * g1.z, s[7 * 33] * g1.w);
        *(v4u*)(WT + (size_t)(d0 + n) * ldk + koff + k0 + 8 * c) = o; } }
    LDS_WAIT(); asm volatile("" ::: "memory");
}

__device__ __forceinline__ void prologue(const Args& a, LAS unsigned char* lds, int gw, int NGW, int wave, int lane, int gtid, int NGT) {
    unsigned char* ws = a.ws;
    LAS float* scr = (LAS float*)(lds + wave * 16384);
    constexpr int I_GU = (D / 64) * (2 * FF / 32), I_D = (FF / 64) * (D / 32), I_KV = (D / 64) * (512 / 32), I_O0 = (D / 64) * (D / 32), I_O1 = (XW / 64) * (D / 32),
                  I_W0 = (D / 64) * (NWIN0 / 32), I_W1 = (D / 64) * (NWIN1 / 32), I_FOLD = 4 * (PG / 8) * (D / 64);
    constexpr int NITEMS = 4 * I_GU + 4 * I_D + 2 * I_KV + I_O0 + I_O1 + I_W0 + I_W1 + I_FOLD;
    for (int it = gw; it < NITEMS; it += NGW) {
        int r = it;
        if (r < 4 * I_GU) { const int idx = r / I_GU, l = idx >> 1, f = idx & 1; r -= idx * I_GU;
            tr_item(a.in[f ? 15 : 3] + (size_t)l * D * 2 * FF, 2 * FF, a.in[f ? 14 : 2] + l * D, (bf16*)(ws + WS_WGU + idx * SZ_WGU), D, 0, 1, scr, r, lane, f8_gu(idx) ? GU8_SCALE : 0.f); continue; }
        r -= 4 * I_GU;
        if (r < 4 * I_D) { const int idx = r / I_D, l = idx >> 1, f = idx & 1; r -= idx * I_D;
            tr_item(a.in[f ? 16 : 4] + (size_t)l * FF * D, D, nullptr, (bf16*)(ws + WS_WD + idx * SZ_WD), FF, 0, 0, scr, r, lane, f8_down(idx) ? W8_SCALE : 0.f); continue; }
        r -= 4 * I_D;
        if (r < 2 * I_KV) { const int l = r / I_KV; r -= l * I_KV;
            tr_item(a.in[7] + (size_t)l * D * 512, 512, nullptr, (bf16*)(ws + WS_WKV + l * SZ_WKV), D, 0, 0, scr, r, lane); continue; }
        r -= 2 * I_KV;
        if (r < I_O0) { tr_item(a.in[8], D, nullptr, (bf16*)(ws + WS_WOUT), D, 0, 0, scr, r, lane); continue; }
        r -= I_O0;
        if (r < I_O1) { tr_item(a.in[8] + (size_t)D * D + (size_t)MW * D, D, nullptr, (bf16*)(ws + WS_WOUT + SZ_WOUT), D, MW, 0, scr, r, lane); continue; }
        r -= I_O1;
        if (r < I_W0) { tr_item(a.in[9], NWIN0, a.in[5], (bf16*)(ws + WS_WIN0), D, 0, 2, scr, r, lane); continue; }
        r -= I_W0;
        if (r < I_W1) { tr_item(a.in[11], NWIN1, a.in[5] + D, (bf16*)(ws + WS_WIN1), D, 0, 0, scr, r, lane); continue; }
        r -= I_W1;
        {
            const int nb = r % (D / 64), kb = (r / (D / 64)) % (PG / 8), g = r / ((D / 64) * (PG / 8));
            const int n = nb * 64 + lane;
            const float* Wg = a.in[12] + (size_t)(g * PG + kb * 8) * PG;
            const float* sc = a.in[13] + g * PG;
            const float* Wo = a.in[8] + (size_t)D * D + (size_t)(g * PG) * D + n;
            float acc[8];
#pragma unroll
            for (int e = 0; e < 8; ++e) acc[e] = 0.f;
            for (int j0 = 0; j0 < PG; j0 += 8) { float wv[8];
#pragma unroll
                for (int jj = 0; jj < 8; ++jj) wv[jj] = Wo[(size_t)(j0 + jj) * D];
#pragma unroll
                for (int jj = 0; jj < 8; ++jj) wv[jj] *= sc[j0 + jj];
#pragma unroll
                for (int e = 0; e < 8; ++e)
#pragma unroll
                    for (int jj = 0; jj < 8; ++jj) acc[e] += Wg[e * PG + j0 + jj] * wv[jj]; }
            v4u o; o.x = pk2(acc[0], acc[1]); o.y = pk2(acc[2], acc[3]); o.z = pk2(acc[4], acc[5]); o.w = pk2(acc[6], acc[7]);
            *(v4u*)((bf16*)(ws + WS_WOUT + SZ_WOUT) + (size_t)n * D + g * PG + kb * 8) = o;
        }
    }
    { const float* x = a.in[0]; bf16* xb = (bf16*)(ws + WS_XB); float* ssq0 = (float*)(ws + WS_SSQ);
      for (int m0 = gw; m0 < M; m0 += 4 * NGW) {
        f32x4 v[4][4];
#pragma unroll
        for (int q = 0; q < 4; ++q) { const int m = m0 + q * NGW; const f32x4* xr = (const f32x4*)(x + (size_t)(m < M ? m : m0) * D) + lane;
#pragma unroll
            for (int j = 0; j < 4; ++j) v[q][j] = __builtin_nontemporal_load(xr + 64 * j); }
#pragma unroll
        for (int q = 0; q < 4; ++q) { const int m = m0 + q * NGW; if (m < M) { float s = 0.f;
#pragma unroll
            for (int j = 0; j < 4; ++j) s += (v[q][j].x * v[q][j].x + v[q][j].y * v[q][j].y) + (v[q][j].z * v[q][j].z + v[q][j].w * v[q][j].w);
            s = wave_sum(s);
            if (lane == 0) ((unsigned*)ssq0)[m] = (unsigned)(s * pg8::SSQ_FX + 0.5f);
            v2u* o8 = (v2u*)(xb + (size_t)m * D) + lane;
#pragma unroll
            for (int j = 0; j < 4; ++j) o8[64 * j] = (v2u){pk2(v[q][j].x, v[q][j].y), pk2(v[q][j].z, v[q][j].w)}; } }
      } }
    for (int t = gw; t < 2 * MROWS; t += NGW) { const int l = t / MROWS, m = t % MROWS;
        const f32x4* xr = (const f32x4*)(a.in[1] + (size_t)m * D) + lane; const f32x4* gr = (const f32x4*)(a.in[6] + l * D) + lane; f32x4 v[4]; float s = 0.f;
#pragma unroll
        for (int j = 0; j < 4; ++j) { v[j] = xr[64 * j]; s += (v[j].x * v[j].x + v[j].y * v[j].y) + (v[j].z * v[j].z + v[j].w * v[j].w); }
        const float r = 1.0f / sqrtf(wave_sum(s) * (1.0f / D) + pg8::RMS_EPS);
        v2u* o8 = (v2u*)((bf16*)(ws + WS_MEMN) + (size_t)t * D) + lane;
#pragma unroll
        for (int j = 0; j < 4; ++j) { const f32x4 g = gr[64 * j]; o8[64 * j] = (v2u){pk2(v[j].x * r * g.x, v[j].y * r * g.y), pk2(v[j].z * r * g.z, v[j].w * r * g.w)}; } }
    { float* z = (float*)(ws + WS_SSQ) + M; for (int i = gtid; i < 6 * M; i += NGT) z[i] = 0.f; }
}

constexpr int KROW = 144, VROW = 528, VOFF = 256 * KROW;
__device__ __forceinline__ void attn_unit(LAS unsigned char* lds, const bf16* z, int ldz, int qoff, const bf16* Kb, const bf16* Vt, bf16* cat, int b, int h, int rc0, int tid, int lane, int wave) {
    const int fr = lane & 15, fq = lane >> 4;
    bf16x8 q0[4], q1[4];
#pragma unroll
    for (int i = 0; i < 4; ++i) { const size_t row = (size_t)b * SEQ + (rc0 + (i >> 1)) * 256 + wave * 32 + (i & 1) * 16 + fr;
        const bf16* qp = z + row * ldz + qoff + h * 64 + fq * 8; q0[i] = *(const bf16x8*)qp; q1[i] = *(const bf16x8*)(qp + 32); }
    { v4u kk[4], vv[4];
#pragma unroll
      for (int q = 0; q < 4; ++q) { const int i = tid + q * 512; kk[q] = *(const v4u*)(Kb + (size_t)(b * NMEM + (i >> 3)) * 256 + h * 64 + (i & 7) * 8); vv[q] = *(const v4u*)(Vt + (size_t)(h * 64 + (i >> 5)) * MROWS + b * NMEM + (i & 31) * 8); }
#pragma unroll
      for (int q = 0; q < 4; ++q) { const int i = tid + q * 512; *(LAS v4u*)(lds + (i >> 3) * KROW + (i & 7) * 16) = kk[q]; *(LAS v4u*)(lds + VOFF + (i >> 5) * VROW + (i & 31) * 16) = vv[q]; } }
    __syncthreads();
#pragma unroll
    for (int sb = 0; sb < 4; ++sb) {
        const size_t row = (size_t)b * SEQ + (rc0 + (sb >> 1)) * 256 + wave * 32 + (sb & 1) * 16 + fr;
        f32x4 s[16];
#pragma unroll
        for (int j = 0; j < 16; ++j) {
            const bf16x8 k0 = *(const LAS bf16x8*)(lds + (16 * j + fr) * KROW + fq * 16), k1 = *(const LAS bf16x8*)(lds + (16 * j + fr) * KROW + fq * 16 + 64);
            f32x4 c = (f32x4){0.f, 0.f, 0.f, 0.f};
            c = __builtin_amdgcn_mfma_f32_16x16x32_bf16(k0, q0[sb], c, 0, 0, 0);
            s[j] = __builtin_amdgcn_mfma_f32_16x16x32_bf16(k1, q1[sb], c, 0, 0, 0);
        }
        float mx = s[0][0];
#pragma unroll
        for (int j = 0; j < 16; ++j) mx = fmaxf(fmaxf(fmaxf(mx, s[j][0]), fmaxf(s[j][1], s[j][2])), s[j][3]);
        mx = fmaxf(mx, __shfl_xor(mx, 16)); mx = fmaxf(mx, __shfl_xor(mx, 32));
        const float sc = 0.125f * 1.4426950408889634f; float sum = 0.f;
#pragma unroll
        for (int j = 0; j < 16; ++j)
#pragma unroll
            for (int i = 0; i < 4; ++i) { const float p = __builtin_amdgcn_exp2f((s[j][i] - mx) * sc); s[j][i] = p; sum += p; }
        sum += __shfl_xor(sum, 16); sum += __shfl_xor(sum, 32);
        f32x4 o[4];
#pragma unroll
        for (int c = 0; c < 4; ++c) o[c] = (f32x4){0.f, 0.f, 0.f, 0.f};
#pragma unroll
        for (int t = 0; t < 8; ++t) {
            const v4u pw = (v4u){pk2(s[2 * t][0], s[2 * t][1]), pk2(s[2 * t][2], s[2 * t][3]), pk2(s[2 * t + 1][0], s[2 * t + 1][1]), pk2(s[2 * t + 1][2], s[2 * t + 1][3])};
            const bf16x8 pb = __builtin_bit_cast(bf16x8, pw);
#pragma unroll
            for (int c = 0; c < 4; ++c) {
                const LAS unsigned char* vp = lds + VOFF + (16 * c + fr) * VROW + (32 * t + 4 * fq) * 2;
                const v2u lo = *(const LAS v2u*)vp, hi = *(const LAS v2u*)(vp + 32);
                const bf16x8 va = __builtin_bit_cast(bf16x8, (v4u){lo.x, lo.y, hi.x, hi.y});
                o[c] = __builtin_amdgcn_mfma_f32_16x16x32_bf16(va, pb, o[c], 0, 0, 0);
            }
        }
        const float inv = 1.0f / sum;
        bf16* op = cat + row * D + MW + h * 64 + 4 * fq;
#pragma unroll
        for (int c = 0; c < 4; ++c) *(v2u*)(op + 16 * c) = (v2u){pk2(o[c][0] * inv, o[c][1] * inv), pk2(o[c][2] * inv, o[c][3] * inv)};
    }
    __syncthreads();
}

#define UNPACK8(p, f) do { f[0] = bflo((p).x); f[1] = bfhi((p).x); f[2] = bflo((p).y); f[3] = bfhi((p).y); f[4] = bflo((p).z); f[5] = bfhi((p).z); f[6] = bflo((p).w); f[7] = bfhi((p).w); } while (0)
__device__ __forceinline__ void conv_mix(const bf16* z, const float* cw, bf16* cat, int gtid, int NGT) {
    for (int idx = gtid; idx < M * (MW / 8); idx += NGT) {
        const int row = idx / (MW / 8), c = idx % (MW / 8), t = row & (SEQ - 1);
        const bf16* zp = z + (size_t)row * LDZ0 + c * 8;
        const v4u pb = *(const v4u*)zp;
        v4u pu[3]; f32x4 w0[3], w1[3];
#pragma unroll
        for (int k = 0; k < 3; ++k) {
            const int dt = 2 - k, back = (t >= dt) ? dt : 0;
            pu[k] = *(const v4u*)(zp - (size_t)back * LDZ0 + MW);
            w0[k] = *(const f32x4*)(cw + k * MW + c * 8); w1[k] = *(const f32x4*)(cw + k * MW + c * 8 + 4);
        }
        float y[8], gb[8]; UNPACK8(pb, gb);
#pragma unroll
        for (int e = 0; e < 8; ++e) y[e] = 0.f;
#pragma unroll
        for (int k = 0; k < 3; ++k) {
            const float mk = (t >= 2 - k) ? 1.0f : 0.0f;
            float uu[8]; UNPACK8(pu[k], uu);
            const f32x4 a0 = w0[k] * mk, a1 = w1[k] * mk;
            y[0] += a0.x * uu[0]; y[1] += a0.y * uu[1]; y[2] += a0.z * uu[2]; y[3] += a0.w * uu[3];
            y[4] += a1.x * uu[4]; y[5] += a1.y * uu[5]; y[6] += a1.z * uu[6]; y[7] += a1.w * uu[7];
        }
        *(v4u*)(cat + (size_t)row * D + c * 8) = (v4u){pk2(gb[0] * y[0], gb[1] * y[1]), pk2(gb[2] * y[2], gb[3] * y[3]), pk2(gb[4] * y[4], gb[5] * y[5]), pk2(gb[6] * y[6], gb[7] * y[7])};
    }
}
template <int W> __device__ __forceinline__ void pool_item(const bf16* zp, int t, bf16* outp) {
    v4u p[W];
#pragma unroll
    for (int i = 0; i < W; ++i) { const int back = (i <= t) ? i : 0; p[i] = *(const v4u*)(zp - (size_t)back * NWIN1); }
    float a[8], p0[8]; UNPACK8(p[0], p0);
#pragma unroll
    for (int e = 0; e < 8; ++e) a[e] = p0[e];
#pragma unroll
    for (int i = 1; i < W; ++i) { float f[8]; UNPACK8(p[i], f); const float mk = (i <= t) ? 1.0f : 0.0f;
#pragma unroll
        for (int e = 0; e < 8; ++e) a[e] += f[e] * mk; }
    const int cnt = (t + 1) < W ? (t + 1) : W; const float ic = 1.0f / (float)cnt;
    *(v4u*)outp = (v4u){pk2(a[0] * ic - p0[0], a[1] * ic - p0[1]), pk2(a[2] * ic - p0[2], a[3] * ic - p0[3]), pk2(a[4] * ic - p0[4], a[5] * ic - p0[5]), pk2(a[6] * ic - p0[6], a[7] * ic - p0[7])};
}
__device__ __forceinline__ void pool_mix(const bf16* z, bf16* cat, int gtid, int NGT) {
    for (int idx = gtid; idx < M * (MW / 8); idx += NGT) {
        const int blk = idx / 192, rem = idx % 192, g = __builtin_amdgcn_readfirstlane(blk / (M / 8)), rb = blk % (M / 8);
        const int row = rb * 8 + rem / 24, c = g * 24 + rem % 24, t = row & (SEQ - 1);
        const bf16* zp = z + (size_t)row * NWIN1 + c * 8; bf16* op = cat + (size_t)row * D + c * 8;
        if (g == 0) pool_item<2>(zp, t, op); else if (g == 1) pool_item<4>(zp, t, op); else if (g == 2) pool_item<8>(zp, t, op); else pool_item<16>(zp, t, op);
    }
}

__global__ void __launch_bounds__(NWAVES * 64, 2) fwd_megakernel(Args a) {
    extern __shared__ __attribute__((aligned(16))) unsigned char lds_raw[];
    LAS unsigned char* lds = (LAS unsigned char*)lds_raw;
    cg::grid_group grid = cg::this_grid();
    const int G = gridDim.x, bx = blockIdx.x;
#define TID_VIEW() int tid = threadIdx.x; asm volatile("" : "+v"(tid)); const int lane = tid & 63, wave = __builtin_amdgcn_readfirstlane(tid >> 6); \
    const int gw = bx * NWAVES + wave, NGW = G * NWAVES, gtid = bx * (NWAVES * 64) + tid, NGT = G * NWAVES * 64; (void)lane; (void)gw; (void)NGW; (void)gtid; (void)NGT;
    unsigned char* ws = a.ws;
    float* ssq = (float*)(ws + WS_SSQ);
    bf16* XB = (bf16*)(ws + WS_XB); bf16* CAT = (bf16*)(ws + WS_CAT); bf16* ACT = (bf16*)(ws + WS_ACT); bf16* Z = ACT;

    if (threadIdx.x < 64) ((LAS unsigned*)(lds + MISC_OFF))[threadIdx.x] = 0u;
    __syncthreads();
    const XcdBarrier bar = xcd_barrier_post((unsigned*)(ws + WS_BAR), (volatile LAS unsigned*)(lds + MISC_OFF));
    grid.sync();
    for (int rep = 0; rep < ((PROBE & 1) ? 2 : 1); ++rep) { TID_VIEW(); prologue(a, lds, gw, NGW, wave, lane, gtid, NGT); }
    xcd_barrier(bar);

#pragma unroll 1
    for (int i = 0; i < 4; ++i) {
        const int l = i >> 1, isv = i & 1;
        const bf16* memn = (const bf16*)(ws + WS_MEMN) + (size_t)l * MROWS * D; const bf16* wkv = (const bf16*)(ws + WS_WKV + l * SZ_WKV);
        pg8::Gemm g{isv ? wkv + (size_t)256 * D : memn, isv ? memn : wkv, isv ? 256 : MROWS, isv ? MROWS : 256, D};
        pg8::StaticOrder S; S.init(g.M, g.N, G, (bx + G - 4 * i) % G);
        pg8::EpiBf16S E{isv ? (bf16*)(ws + WS_VT) + (size_t)l * 256 * MROWS : (bf16*)(ws + WS_KB) + (size_t)l * MROWS * 256, isv ? MROWS : 256, nullptr};
        pg8::gemm_phase<pg8::EpiBf16S, pg8::StaticOrder, K_ALIGN, K_SP2>(lds, (LAS float*)(lds + RS_OFF), g, S, E);
    }

#pragma unroll 1
    for (int step = 0; step < 14; ++step) {
        const int l = step / 7, s = step % 7;
        if (s == 0 || s == 5) {
            const int f = (s == 5) ? 1 : 0;
            pg8::Gemm g{XB, (const bf16*)(ws + WS_WGU + (2 * l + f) * SZ_WGU), M, 2 * FF, D};
            pg8::StaticOrder S; S.init(M, 2 * FF, G, bx);
            static_assert((F8_GU & ~F8_DOWN) == 0 && (F8_GU & 5) == 0, "an FP8 gate|up projection is only wired for FFN 2 (its e4m3 input copy comes from the W_out epilogue) and together with an FP8 down projection");
            if (f8_gu(2 * l + f)) {
                pg8::Gemm g8{(const bf16*)(ws + WS_XB8), g.Bt, M, 2 * FF, D / 2};
                pg8::EpiSwiglu88 E{ACT, ssq + (size_t)(3 * l + 2 * f) * M, FF};
                pg8::gemm_phase<pg8::EpiSwiglu88, pg8::StaticOrder, K_ALIGN, K_SP2>(lds, (LAS float*)(lds + RS_OFF), g8, S, E);
            } else if (f8_down(2 * l + f)) { pg8::EpiSwiglu8 E{ACT, ssq + (size_t)(3 * l + 2 * f) * M, FF};
                pg8::gemm_phase<pg8::EpiSwiglu8, pg8::StaticOrder, K_ALIGN, K_SP2>(lds, (LAS float*)(lds + RS_OFF), g, S, E);
            } else { pg8::EpiSwiglu E{ACT, ssq + (size_t)(3 * l + 2 * f) * M, FF};
                pg8::gemm_phase<pg8::EpiSwiglu, pg8::StaticOrder, K_ALIGN, K_SP2>(lds, (LAS float*)(lds + RS_OFF), g, S, E); }
#if (PROBE & 512)
            { struct FixedOrder : pg8::StaticOrder { __device__ bool next(int i, pg8::Unit& u) const { const long L = (long)i * G + c; if (L >= nwg) return false; u.pm = c % 8; u.pn = (c / 8) % 4; return true; } };
              FixedOrder SF; SF.init(M, 2 * FF, G, bx); pg8::EpiNull EN{(float*)(ws + 7 * MiB)}; pg8::gemm_phase<pg8::EpiNull, FixedOrder, K_ALIGN, K_SP2>(lds, (LAS float*)(lds + RS_OFF), g, SF, EN); }
#endif
#if (PROBE & 256)
            { pg8::EpiNull EN{(float*)(ws + 7 * MiB)}; pg8::gemm_phase<pg8::EpiNull, pg8::StaticOrder, K_ALIGN, K_SP2>(lds, (LAS float*)(lds + RS_OFF), g, S, EN); }
#endif
        } else if (s == 1 || s == 4 || s == 6) {
            const int f = (s == 6) ? 1 : 0; const bool isout = (s == 4);
            pg8::Gemm g{isout ? CAT : ACT, isout ? (const bf16*)(ws + WS_WOUT + l * SZ_WOUT) : (const bf16*)(ws + WS_WD + (2 * l + f) * SZ_WD), M, D, isout ? D : FF};
            pg8::StaticOrder S; S.init(M, D, G, bx);
#if (PROBE & 24)
            if (((PROBE & 8) && !isout) || ((PROBE & 16) && isout)) {
                pg8::EpiResid E0{(step == 1) ? a.in[0] : nullptr, isout ? ACT : CAT, (float*)(ws + 7 * MiB), isout ? 1.0f : 0.5f};
                pg8::gemm_phase<pg8::EpiResid, pg8::StaticOrder, K_ALIGN, K_SP2_RESID>(lds, (LAS float*)(lds + RS_OFF), g, S, E0); }
#endif
            if (!isout && f8_down(2 * l + f)) {
                pg8::Gemm g8{ACT, g.Bt, M, D, FF / 2};
                pg8::EpiResid8 E{(step == 1) ? a.in[0] : nullptr, XB, ssq + (size_t)(3 * l + 1 + 2 * f) * M, 0.5f / W8_SCALE};
                pg8::gemm_phase<pg8::EpiResid8, pg8::StaticOrder, K_ALIGN, K_SP2_RESID>(lds, (LAS float*)(lds + RS_OFF), g8, S, E);
            } else {
            if (isout && f8_gu(2 * l + 1)) {
                typedef pg8::EpiResidT<false, (long)(WS_XB8 - WS_XB)> EpiResidX8;
                EpiResidX8 E{nullptr, XB, ssq + (size_t)(3 * l + 2) * M, 1.0f};
                pg8::gemm_phase<EpiResidX8, pg8::StaticOrder, K_ALIGN, K_SP2_RESID>(lds, (LAS float*)(lds + RS_OFF), g, S, E);
            } else {
            pg8::EpiResid E{(step == 1) ? a.in[0] : nullptr, XB, ssq + (size_t)(3 * l + (isout ? 2 : 1 + 2 * f)) * M, isout ? 1.0f : 0.5f};
            pg8::gemm_phase<pg8::EpiResid, pg8::StaticOrder, K_ALIGN, K_SP2_RESID>(lds, (LAS float*)(lds + RS_OFF), g, S, E); } }
        } else if (s == 2) {
            const int N = l ? NWIN1 : NWIN0;
            pg8::Gemm g{XB, (const bf16*)(ws + (l ? WS_WIN1 : WS_WIN0)), M, N, D};
            pg8::StaticOrder S; S.init(M, N, G, bx);
            if (l == 0) { pg8::EpiWin0 E{Z, ssq + (size_t)(3 * l + 1) * M};
                pg8::gemm_phase<pg8::EpiWin0, pg8::StaticOrder, K_ALIGN, K_SP2>(lds, (LAS float*)(lds + RS_OFF), g, S, E);
            } else { pg8::EpiBf16S E{Z, N, ssq + (size_t)(3 * l + 1) * M};
                pg8::gemm_phase<pg8::EpiBf16S, pg8::StaticOrder, K_ALIGN, K_SP2>(lds, (LAS float*)(lds + RS_OFF), g, S, E); }
        } else {
            for (int rep = 0; rep < ((PROBE & 4) ? 2 : 1); ++rep) {
            TID_VIEW();
            const int ldz = l ? NWIN1 : LDZ0, qoff = l ? MW : 2 * MW;
            const bf16* Kb = (const bf16*)(ws + WS_KB) + (size_t)l * MROWS * 256; const bf16* Vt = (const bf16*)(ws + WS_VT) + (size_t)l * 256 * MROWS;
            for (int u = bx; u < NB * 4 * (SEQ / 512); u += G) { const int rp = u % (SEQ / 512), bh = u / (SEQ / 512);
                attn_unit(lds, Z, ldz, qoff, Kb, Vt, CAT, bh >> 2, bh & 3, 2 * rp, tid, lane, wave); }
            if (l == 0) conv_mix(Z, a.in[10], CAT, gtid, NGT); else pool_mix(Z, CAT, gtid, NGT);
            }
        }
        xcd_barrier(bar);
        if (PROBE & 64) xcd_barrier(bar);
    }
    for (int rep = 0; rep < ((PROBE & 128) ? 2 : 1); ++rep) { TID_VIEW(); const float* sq = ssq + (size_t)6 * M; const f32x4* gr = (const f32x4*)a.in[17] + lane * 2;
      const f32x4 g0 = gr[0], g1 = gr[1], g2 = gr[128], g3 = gr[129];
      for (int m0 = gw; m0 < M; m0 += 4 * NGW) {
        v4u p[4][2];
#pragma unroll
        for (int q = 0; q < 4; ++q) { const int m = m0 + q * NGW; const v4u* xr = (const v4u*)(XB + (size_t)(m < M ? m : m0) * D) + lane; p[q][0] = xr[0]; p[q][1] = xr[64]; }
#pragma unroll
        for (int q = 0; q < 4; ++q) { const int m = m0 + q * NGW; if (m < M) { const float r = pg8::rstd_of(sq, m); f32x4* orow = (f32x4*)(a.out + (size_t)m * D) + lane * 2;
            float f[8]; UNPACK8(p[q][0], f);
            orow[0] = (f32x4){f[0] * r * g0.x, f[1] * r * g0.y, f[2] * r * g0.z, f[3] * r * g0.w}; orow[1] = (f32x4){f[4] * r * g1.x, f[5] * r * g1.y, f[6] * r * g1.z, f[7] * r * g1.w};
            UNPACK8(p[q][1], f);
            orow[128] = (f32x4){f[0] * r * g2.x, f[1] * r * g2.y, f[2] * r * g2.z, f[3] * r * g2.w}; orow[129] = (f32x4){f[4] * r * g3.x, f[5] * r * g3.y, f[6] * r * g3.z, f[7] * r * g3.w}; } }
      } }
}

extern "C" void kernel_launch(void* const* d_in, const int* in_sizes, int n_in, void* d_out, int out_size, void* d_ws, size_t ws_size, hipStream_t stream) {
    static int grid = 0;
    if (grid == 0) {
        if (n_in != 18 || in_sizes[0] != M * D || out_size != M * D || ws_size < WS_END) { fprintf(stderr, "kernel_launch: unexpected shapes (n_in %d, in0 %d, out %d, ws %zu)\n", n_in, n_in > 0 ? in_sizes[0] : -1, out_size, ws_size); grid = -1; return; }
        int dev = 0, cus = 0, per_cu = 0;
        if (hipGetDevice(&dev) != hipSuccess || hipDeviceGetAttribute(&cus, hipDeviceAttributeMultiprocessorCount, dev) != hipSuccess) { grid = -1; return; }
        if (hipFuncSetAttribute((const void*)fwd_megakernel, hipFuncAttributeMaxDynamicSharedMemorySize, LDS_BYTES) != hipSuccess) { fprintf(stderr, "kernel_launch: hipFuncSetAttribute failed\n"); grid = -1; return; }
        if (hipOccupancyMaxActiveBlocksPerMultiprocessor(&per_cu, (const void*)fwd_megakernel, NWAVES * 64, LDS_BYTES) != hipSuccess || per_cu < 1) { fprintf(stderr, "kernel_launch: occupancy query says %d\n", per_cu); per_cu = 1; }
        (void)hipGetLastError();
        grid = cus * 1;
    }
    if (grid < 0) return;
    Args a{};
    for (int i = 0; i < 18; ++i) a.in[i] = (const float*)d_in[i];
    a.out = (float*)d_out; a.ws = (unsigned char*)d_ws;
    if (hipMemsetAsync((char*)d_ws + WS_BAR, 0, BAR_ZERO_BYTES, stream) != hipSuccess) { fprintf(stderr, "kernel_launch: memset failed\n"); return; }
    void* args[] = {&a};
    hipError_t e = hipLaunchCooperativeKernel((const void*)fwd_megakernel, dim3(grid), dim3(NWAVES * 64), args, LDS_BYTES, stream);
    if (e != hipSuccess) fprintf(stderr, "kernel_launch: cooperative launch failed: %s (grid %d)\n", hipGetErrorString(e), grid);
}
```
